# Optimizing an MI355X kernel written in HIP

```python
import math
import jax, jax.numpy as jnp
from jax import lax
import numpy as np

D_MODEL = 1024
BATCH = 32
SEQ = 2048
DEPTH = 2
DEC_BATCH = 16
DEC_SEQ = 16
PAST_LEN = 1024

CHUNK = 64
Q_BLOCK = 128
EPS = 1e-6
W_CONV = 512
CONV_WIDTH = 3
HG_HEADS = 4
HG_DK = 128
HG_DV = 128
W_HG = HG_HEADS * HG_DV
SB_HEADS = 8
SB_DH = 64
W_SB = SB_HEADS * SB_DH
W_MIX = W_CONV + W_HG + W_SB
SEG_SIZES = (W_CONV, W_CONV, W_CONV, W_CONV,
             HG_HEADS * HG_DK, HG_HEADS * HG_DK, W_HG, W_HG,
             W_SB, W_SB, W_SB, W_SB,
             D_MODEL, D_MODEL, D_MODEL)
D_IN = sum(SEG_SIZES)

kernel_name = "hybrid_conv_hgrn2_stickbreak_stream_step"


def rms_norm(x, g):
    xf = x.astype(jnp.float32)
    y = xf * lax.rsqrt(jnp.mean(xf * xf, axis=-1, keepdims=True) + EPS)
    return (y * g.astype(jnp.float32)).astype(x.dtype)


def split_cols(p):
    out = []
    start = 0
    for size in SEG_SIZES:
        out.append(p[..., start:start + size])
        start += size
    return out


def causal_conv(u, w, past):
    T = u.shape[1]
    full = jnp.concatenate([past.astype(u.dtype), u], axis=1)
    y = full[:, 0:T] * w[0]
    for j in range(1, CONV_WIDTH):
        y = y + full[:, j:j + T] * w[j]
    return y, full[:, T:]


def hgrn_chunk(S, inp):
    q, logf, k, v = inp
    L = q.shape[1]
    b = jnp.cumsum(logf, axis=1)
    tri = jnp.tril(jnp.ones((L, L), dtype=bool))[None, :, :, None, None]
    decay = jnp.exp(jnp.where(tri, b[:, :, None] - b[:, None, :], -jnp.inf))
    scores = jnp.einsum('bthk,btshk,bshk->bhts', q, decay, k)
    o = (jnp.einsum('bhts,bshv->bthv', scores, v)
         + jnp.einsum('bthk,bhkv->bthv', q * jnp.exp(b), S))
    b_last = b[:, -1]
    S_new = (jnp.exp(b_last)[..., None] * S
             + jnp.einsum('bshk,bshv->bhkv', k * jnp.exp(b_last[:, None] - b), v))
    return S_new, o


def hgrn_scan(S0, q, logf, k, v):
    B, T = q.shape[:2]
    L = min(CHUNK, T)
    n = T // L

    def to_chunks(a):
        return a.reshape(B, n, L, *a.shape[2:]).swapaxes(0, 1)

    S, o = lax.scan(hgrn_chunk, S0, (to_chunks(q), to_chunks(logf), to_chunks(k), to_chunks(v)))
    return S, o.swapaxes(0, 1).reshape(B, T, HG_HEADS, HG_DV)


def sb_attend(q, k, v, q_pos, k_pos):
    qf = q.astype(jnp.float32)
    kf = k.astype(jnp.float32)
    vf = v.astype(jnp.float32)
    z = jnp.einsum('bqhd,bkhd->bhqk', qf, kf) * (1.0 / math.sqrt(SB_DH))
    causal = (k_pos[None, :] < q_pos[:, None])[None, None]
    log_1mb = jnp.where(causal, jax.nn.log_sigmoid(-z), 0.0)
    rest = lax.cumsum(log_1mb, axis=3, reverse=True) - log_1mb
    A = jnp.where(causal, jnp.exp(jax.nn.log_sigmoid(z) + rest), 0.0)
    return jnp.einsum('bhqk,bkhd->bqhd', A, vf)


def sb_prompt(q, k, v):
    B, T = q.shape[:2]
    nb = T // Q_BLOCK
    qb = q.reshape(B, nb, Q_BLOCK, SB_HEADS, SB_DH).swapaxes(0, 1)
    posb = jnp.arange(T).reshape(nb, Q_BLOCK)
    k_pos = jnp.arange(T)
    o = lax.map(lambda a: sb_attend(a[0], k, v, a[1], k_pos), (qb, posb))
    return o.swapaxes(0, 1).reshape(B, T, SB_HEADS, SB_DH)


def mixer_layer(x, l, conv_past, S0, past_k, past_v, norm_g, w_in, conv_w, lb,
                hg_norm_g, q_norm_g, k_norm_g, w_branch, w_out):
    B, T, _ = x.shape
    f32 = jnp.float32
    h = rms_norm(x, norm_g[l])
    (a_x, a_b, a_c, a_z, g_q, g_f, g_i, g_z,
     s_q, s_k, s_v, s_z, m_a, m_b, m_c) = split_cols(h @ w_in[l])

    y_conv, conv_new = causal_conv(a_c * a_x, conv_w[l], conv_past)
    o_a = a_b * y_conv * jax.nn.silu(a_z)

    lb_l = lb[l].reshape(HG_HEADS, HG_DK)
    fpre = g_f.astype(f32).reshape(B, T, HG_HEADS, HG_DK)
    log_f = jnp.logaddexp(jnp.log(lb_l), jnp.log1p(-lb_l) + jax.nn.log_sigmoid(fpre))
    k_in = (1.0 - lb_l) * jax.nn.sigmoid(-fpre)
    q_hg = g_q.astype(f32).reshape(B, T, HG_HEADS, HG_DK)
    v_hg = g_i.astype(f32).reshape(B, T, HG_HEADS, HG_DV)
    S_new, o_hg = hgrn_scan(S0.astype(f32), q_hg, log_f, k_in, v_hg)
    o_hg = rms_norm(o_hg, hg_norm_g[l]).reshape(B, T, W_HG).astype(x.dtype)
    o_b = o_hg * jax.nn.silu(g_z)

    q = rms_norm(s_q.reshape(B, T, SB_HEADS, SB_DH), q_norm_g[l])
    k = rms_norm(s_k.reshape(B, T, SB_HEADS, SB_DH), k_norm_g[l])
    v = s_v.reshape(B, T, SB_HEADS, SB_DH)
    if past_k is None:
        o_sb = sb_prompt(q, k, v)
    else:
        P = past_k.shape[1]
        k_all = jnp.concatenate([past_k.astype(k.dtype), k], axis=1)
        v_all = jnp.concatenate([past_v.astype(v.dtype), v], axis=1)
        o_sb = sb_attend(q, k_all, v_all, P + jnp.arange(T), jnp.arange(P + T))
    o_c = o_sb.reshape(B, T, W_SB).astype(x.dtype) * jax.nn.silu(s_z)

    wb = w_branch[l]
    y_a = o_a @ wb[:W_CONV]
    y_b = o_b @ wb[W_CONV:W_CONV + W_HG]
    y_c = o_c @ wb[W_CONV + W_HG:]
    m = jax.nn.sigmoid(m_a) * y_a + jax.nn.sigmoid(m_b) * y_b + jax.nn.sigmoid(m_c) * y_c
    return x + m @ w_out[l], conv_new, S_new.astype(x.dtype), k, v


def setup_inputs(seed: int = 0) -> dict:
    key = jax.random.key(seed)
    ks = jax.random.split(key, 16)
    nrm = jax.random.normal
    return {
        'x_prompt': nrm(ks[0], (BATCH, SEQ, D_MODEL), jnp.float32),
        'x_sample': nrm(ks[1], (DEC_BATCH, DEC_SEQ, D_MODEL), jnp.float32),
        'cache_conv': nrm(ks[2], (DEPTH, DEC_BATCH, CONV_WIDTH - 1, W_CONV), jnp.float32),
        'state_hgrn': 0.5 * nrm(ks[3], (DEPTH, DEC_BATCH, HG_HEADS, HG_DK, HG_DV), jnp.float32),
        'cache_k': nrm(ks[4], (DEPTH, DEC_BATCH, PAST_LEN, SB_HEADS, SB_DH), jnp.float32),
        'cache_v': nrm(ks[5], (DEPTH, DEC_BATCH, PAST_LEN, SB_HEADS, SB_DH), jnp.float32),
        'norm_g': 1.0 + 0.1 * nrm(ks[6], (DEPTH, D_MODEL), jnp.float32),
        'w_in': nrm(ks[7], (DEPTH, D_MODEL, D_IN), jnp.float32) * D_MODEL ** -0.5,
        'conv_w': 0.5 * nrm(ks[8], (DEPTH, CONV_WIDTH, W_CONV), jnp.float32),
        'hg_lb_logits': nrm(ks[9], (DEPTH, HG_HEADS * HG_DK), jnp.float32),
        'hg_norm_g': 1.0 + 0.1 * nrm(ks[10], (DEPTH, HG_DV), jnp.float32),
        'q_norm_g': 1.0 + 0.1 * nrm(ks[11], (DEPTH, SB_DH), jnp.float32),
        'k_norm_g': 1.0 + 0.1 * nrm(ks[12], (DEPTH, SB_DH), jnp.float32),
        'w_branch': nrm(ks[13], (DEPTH, W_MIX, D_MODEL), jnp.float32) * W_CONV ** -0.5,
        'w_out': 0.5 * nrm(ks[14], (DEPTH, D_MODEL, D_MODEL), jnp.float32) * D_MODEL ** -0.5,
    }


def reference(x_prompt, x_sample, cache_conv, state_hgrn, cache_k, cache_v, norm_g, w_in, conv_w,
              hg_lb_logits, hg_norm_g, q_norm_g, k_norm_g, w_branch, w_out):
    lb_cum = jnp.cumsum(jax.nn.softmax(hg_lb_logits.astype(jnp.float32), axis=0), axis=0)
    lb = lb_cum - lb_cum[0:1]
    weights = (norm_g, w_in, conv_w, lb, hg_norm_g, q_norm_g, k_norm_g, w_branch, w_out)
    Bp = x_prompt.shape[0]
    conv_zero = jnp.zeros((Bp, CONV_WIDTH - 1, W_CONV), x_prompt.dtype)
    S_zero = jnp.zeros((Bp, HG_HEADS, HG_DK, HG_DV), jnp.float32)
    yp, ys = x_prompt, x_sample
    cp, cs, hp, hs, kp, ksl, vp, vs = [], [], [], [], [], [], [], []
    for l in range(DEPTH):
        yp, c1, s1, k1, v1 = mixer_layer(yp, l, conv_zero, S_zero, None, None, *weights)
        ys, c2, s2, k2, v2 = mixer_layer(ys, l, cache_conv[l], state_hgrn[l], cache_k[l], cache_v[l], *weights)
        cp.append(c1); hp.append(s1); kp.append(k1); vp.append(v1)
        cs.append(c2); hs.append(s2); ksl.append(k2); vs.append(v2)
    conv_prompt = jnp.stack(cp)
    conv_sample = jnp.stack(cs)
    hgrn_prompt = jnp.stack(hp)
    hgrn_sample = jnp.stack(hs)
    k_prompt = jnp.stack(kp)
    k_sample = jnp.stack(ksl)
    v_prompt = jnp.stack(vp)
    v_sample = jnp.stack(vs)
    return (yp, ys, conv_prompt, conv_sample, hgrn_prompt, hgrn_sample, k_prompt, k_sample, v_prompt, v_sample)
```

```cpp
#include <hip/hip_runtime.h>
#include <hip/hip_cooperative_groups.h>
#include <cstdio>
namespace cg = cooperative_groups;

typedef unsigned short u16;
using bf16x8 = __attribute__((ext_vector_type(8))) short;
using bf16x4 = __attribute__((ext_vector_type(4))) short;
using f32x4  = __attribute__((ext_vector_type(4))) float;

#define NTOK 65792
#define NP   65536
#define NTHR 512
#define LDS_BYTES 131328
#define EPSV 1e-6f

struct Params {
  const float* xp; const float* xs; const float* cconv; const float* shg; const float* ck; const float* cv;
  const float* norm_g; const float* w_in; const float* conv_w; const float* lb_logits; const float* hg_g;
  const float* q_g; const float* k_g; const float* w_br; const float* w_out;
  float* out;
  u16* wt_in; u16* wt_br; u16* wt_out;
  u16* h;
  u16* u; u16* hv;
  u16* gza; u16* hq; u16* gzb; u16* sq; u16* gzc;
  float* logf;
  u16* m;
  float* lbv;
  int* ctr;
  unsigned* bar;
  char* gbuf; char* mbuf;
};

extern __shared__ __attribute__((aligned(16))) char smem[];

__device__ __forceinline__ int otid() { int t = threadIdx.x; asm volatile("" : "+v"(t)); return t; }

__device__ __forceinline__ u16 f2bf(float f) {
  unsigned u = __float_as_uint(f);
  u += 0x7fffu + ((u >> 16) & 1u);
  return (u16)(u >> 16);
}
__device__ __forceinline__ float bf2f(u16 h) { return __uint_as_float(((unsigned)h) << 16); }
__device__ __forceinline__ float fexp(float x) { return __builtin_amdgcn_exp2f(x * 1.44269504f); }
__device__ __forceinline__ float flog(float x) { return __builtin_amdgcn_logf(x) * 0.69314718f; }
__device__ __forceinline__ float sigmoidf_(float x) { return __builtin_amdgcn_rcpf(1.f + fexp(-x)); }
__device__ __forceinline__ float siluf_(float x) { return x * __builtin_amdgcn_rcpf(1.f + fexp(-x)); }
__device__ __forceinline__ unsigned pack2_t(float a, float b) { unsigned r; asm volatile("s_nop 1\n\tv_cvt_pk_bf16_f32 %0, %1, %2" : "=v"(r) : "v"(a), "v"(b)); return r; }
__device__ __forceinline__ unsigned pack2(float a, float b) { unsigned r; asm volatile("v_cvt_pk_bf16_f32 %0, %1, %2" : "=v"(r) : "v"(a), "v"(b)); return r; }

#define OFF_Y      0L
#define OFF_CONVP  67371008L
#define OFF_CONVS  (OFF_CONVP + 65536L)
#define OFF_HGP    (OFF_CONVS + 32768L)
#define OFF_HGS    (OFF_HGP + 4194304L)
#define OFF_KP     (OFF_HGS + 2097152L)
#define OFF_KS     (OFF_KP + 67108864L)
#define OFF_VP     (OFF_KS + 262144L)
#define OFF_VS     (OFF_VP + 67108864L)

__device__ __forceinline__ int perm256(int v) {
  const int bj = v >> 7, wc = (v >> 5) & 3, n = (v >> 4) & 1, fq = (v >> 2) & 3, j = v & 3;
  return 128 * bj + 32 * wc + 8 * fq + 4 * n + j;
}
__device__ __forceinline__ int real_col(int V) {
  const int pn = V >> 8, v = V & 255;
  if (V >= 6144) return (V & ~255) + perm256(v);
  const int bj = v >> 7, wc = (v >> 5) & 3, n = (v >> 4) & 1, fq = (v >> 2) & 3, j = v & 3;
  if (pn < 8) {
    const int seg = (pn < 4) ? (bj ? 2 : 0) : (bj ? 3 : 1);
    return seg * 512 + (pn & 3) * 128 + 32 * wc + 8 * fq + 4 * n + j;
  }
  if (pn < 16) {
    const int seg = (pn - 8) >> 1;
    return (seg == 1) ? V : (V & ~255) + perm256(v);
  }
  const int s = (pn - 16) >> 1, head = ((pn - 16) & 1) * 4 + wc;
  const int d = (s == 0 || s == 3) ? (32 * bj + 8 * fq + 4 * n + j) : (32 * bj + 16 * n + 4 * fq + j);
  return 4096 + s * 512 + head * 64 + d;
}

#define XB_TMO      128
#define XB_XCNT(j)  (256  + 64 * (j))
#define XB_XSUB(j)  (1280 + 64 * (j))
#define XB_XGEN(j)  (2304 + 64 * (j))
#define XB_TOP      3328
#define XB_TOPGEN   3392
#define XCD_BAR_WORDS 3456
#define XB_SPIN_CAP (1u << 18)
#ifndef LAS
#define LAS __attribute__((address_space(3)))
#endif

__device__ __forceinline__ unsigned xb_ld(unsigned* p)              { return __hip_atomic_load(p, __ATOMIC_RELAXED, __HIP_MEMORY_SCOPE_AGENT); }
__device__ __forceinline__ unsigned xb_add(unsigned* p, unsigned v) { return __hip_atomic_fetch_add(p, v, __ATOMIC_RELAXED, __HIP_MEMORY_SCOPE_AGENT); }
__device__ __forceinline__ unsigned xb_xcc_id() { return (unsigned)__builtin_amdgcn_s_getreg((3 << 11) | 20) & 0xFu; }
#define XB_SPIN(cond, bar) do { unsigned _sp = 0; while (cond) { __builtin_amdgcn_s_sleep(1); \
    if ((++_sp & 255u) == 0u) { if (xb_ld(&(bar)[XB_TMO])) break; if (_sp > XB_SPIN_CAP) { atomicAdd(&(bar)[XB_TMO], 1u); break; } } } } while (0)

struct XcdBarrier {
    unsigned* bar; unsigned x;
    volatile LAS unsigned* st;
};

__device__ __forceinline__ XcdBarrier xcd_barrier_post(unsigned* bar, volatile LAS unsigned* st) {
    XcdBarrier b; b.bar = bar; b.x = xb_xcc_id(); b.st = st;
    if (threadIdx.x == 0) (void)xb_add(&bar[XB_XCNT(b.x)], 1u);
    return b;
}
__device__ __forceinline__ void xcd_barrier_complete(unsigned* bar, unsigned x, unsigned& nloc, unsigned& nx) {
    const unsigned G = gridDim.x * gridDim.y * gridDim.z;
    unsigned sum, cnt, mine, sp = 0u;
    for (;;) {
        sum = 0u; cnt = 0u; mine = 0u;
#pragma unroll
        for (unsigned j = 0; j < 16; ++j) { const unsigned c = xb_ld(&bar[XB_XCNT(j)]); sum += c; cnt += (c > 0u) ? 1u : 0u; mine = (j == x) ? c : mine; }
        if (sum == G) break;
        __builtin_amdgcn_s_sleep(1);
        if ((++sp & 255u) == 0u) { if (xb_ld(&bar[XB_TMO])) break; if (sp > XB_SPIN_CAP) { atomicAdd(&bar[XB_TMO], 1u); break; } }
    }
    nloc = mine > 0u ? mine : 1u; nx = cnt > 0u ? cnt : 1u;
}

__device__ __forceinline__ void xcd_barrier(const XcdBarrier& b) {
    asm volatile("s_waitcnt vmcnt(0)" ::: "memory");
    __syncthreads();
    if (threadIdx.x == 0) {
        unsigned* bar = b.bar;
        __builtin_amdgcn_s_waitcnt(0);
        unsigned nloc = b.st[0], nx = b.st[1];
        if (nloc == 0u) { xcd_barrier_complete(bar, b.x, nloc, nx); b.st[0] = nloc; b.st[1] = nx; }
        const unsigned old = xb_add(&bar[XB_XSUB(b.x)], 1u);
        const unsigned gen = old / nloc;
        if (old + 1u == (gen + 1u) * nloc) {
            __builtin_amdgcn_fence(__ATOMIC_RELEASE, "agent");
            asm volatile("s_waitcnt vmcnt(0)" ::: "memory");
            const unsigned og = xb_add(&bar[XB_TOP], 1u);
            const unsigned tg = og / nx;
            if (og + 1u == (tg + 1u) * nx) xb_add(&bar[XB_TOPGEN], 1u);
            else XB_SPIN(xb_ld(&bar[XB_TOPGEN]) == tg, bar);
            __builtin_amdgcn_fence(__ATOMIC_ACQUIRE, "agent");
            xb_add(&bar[XB_XGEN(b.x)], 1u);
            asm volatile("s_waitcnt vmcnt(0)" ::: "memory");
        } else {
            XB_SPIN(xb_ld(&bar[XB_XGEN(b.x)]) == gen, bar);
            __builtin_amdgcn_fence(__ATOMIC_ACQUIRE, "agent");
            asm volatile("s_waitcnt vmcnt(0)" ::: "memory");
        }
    }
    __syncthreads();
}


__device__ __forceinline__ void grid_bar(unsigned* bar) {
  XcdBarrier b; b.bar = bar; b.x = xb_xcc_id(); b.st = (volatile LAS unsigned*)(smem + LDS_BYTES - 32);
  xcd_barrier(b);
}

struct TDesc { const float* src; u16* dst; int ld, K, k0, n0, mode; };
__device__ __forceinline__ TDesc tile_desc(const Params& p, int t) {
  TDesc d; const int l = t / 2944; int r = t % 2944;
  if (r < 2304) { const int kt = r / 144, nt = r % 144;
    d.src = p.w_in + (long)l * 1024 * 9216; d.ld = 9216; d.dst = p.wt_in + (long)l * 9216 * 1024; d.K = 1024; d.k0 = kt * 64; d.n0 = nt * 64; d.mode = 1;
  } else if (r < 2304 + 384) { r -= 2304; const int br = r >> 7, kt = (r & 127) >> 4, nt = r & 15;
    d.src = p.w_br + (long)l * 1536 * 1024 + (long)br * 512 * 1024; d.ld = 1024; d.dst = p.wt_br + (long)(l * 3 + br) * 1024 * 512; d.K = 512; d.k0 = kt * 64; d.n0 = nt * 64; d.mode = 2;
  } else { r -= 2304 + 384; const int kt = r / 16, nt = r % 16;
    d.src = p.w_out + (long)l * 1024 * 1024; d.ld = 1024; d.dst = p.wt_out + (long)l * 1024 * 1024; d.K = 1024; d.k0 = kt * 64; d.n0 = nt * 64; d.mode = 0;
  }
  return d;
}
__device__ __forceinline__ void tt_load(const TDesc& d, float* t, int tid) {
#pragma unroll
  for (int i = 0; i < 2; ++i) {
    const int e = tid + i * NTHR, kk = e >> 4, q = e & 15, nv = d.n0 + 4 * q;
    const int col = (d.mode == 1) ? real_col(nv) : (d.mode == 2) ? (nv & ~255) + perm256(nv & 255) : nv;
    const float4 v = *reinterpret_cast<const float4*>(d.src + (long)(d.k0 + kk) * d.ld + col);
    float* w = t + kk * 65 + 4 * q; w[0] = v.x; w[1] = v.y; w[2] = v.z; w[3] = v.w;
  }
}
__device__ __forceinline__ void tt_store(const TDesc& d, const float* t, int tid) {
  const int nn = tid >> 3, c8 = tid & 7;
  float f[8];
#pragma unroll
  for (int i = 0; i < 8; ++i) f[i] = t[(8 * c8 + i) * 65 + nn];
  uint4 o; o.x = pack2(f[0], f[1]); o.y = pack2(f[2], f[3]); o.z = pack2(f[4], f[5]); o.w = pack2(f[6], f[7]);
  *reinterpret_cast<uint4*>(d.dst + (long)(d.n0 + nn) * d.K + d.k0 + 8 * c8) = o;
}

__device__ __forceinline__ void phase_prep(const Params& p) {
  if (blockIdx.x == 0) {
    for (int i = threadIdx.x; i < 512; i += NTHR) {
      float l0 = p.lb_logits[i], l1 = p.lb_logits[512 + i];
      p.lbv[i] = 0.f;
      p.lbv[512 + i] = 1.f / (1.f + expf(l0 - l1));
    }
    if (threadIdx.x < 16) p.ctr[threadIdx.x] = 0;
    for (int i = threadIdx.x; i < XCD_BAR_WORDS; i += NTHR) p.bar[i] = 0u;
  }
  const int tid = otid();
  float* t0 = reinterpret_cast<float*>(smem); float* t1 = t0 + 64 * 65;
  for (int t = blockIdx.x; t < 2 * 2944; t += 2 * gridDim.x) {
    const int tb = t + gridDim.x; const bool two = tb < 2 * 2944;
    const TDesc d0 = tile_desc(p, t), d1 = tile_desc(p, two ? tb : t);
    tt_load(d0, t0, tid);
    if (two) tt_load(d1, t1, tid);
    __syncthreads();
    tt_store(d0, t0, tid);
    if (two) tt_store(d1, t1, tid);
    __syncthreads();
  }
}

__device__ __forceinline__ void phase_norm(const Params& p, int l) {
  const int tid = otid(), wid = tid >> 6, lane = tid & 63;
  const float* g = p.norm_g + l * 1024;
  float4 gg[4];
#pragma unroll
  for (int i = 0; i < 4; ++i) gg[i] = *reinterpret_cast<const float4*>(g + (i * 64 + lane) * 4);
  for (int row = (blockIdx.x * 8 + wid) * 2; row < NTOK; row += gridDim.x * 16) {
    float4 v[2][4]; float ss[2] = {0.f, 0.f};
#pragma unroll
    for (int r = 0; r < 2; ++r) {
      const int rr = row + r;
      const float* x = (l == 0) ? (rr < NP ? p.xp + (long)rr * 1024 : p.xs + (long)(rr - NP) * 1024) : p.out + (long)rr * 1024;
#pragma unroll
      for (int i = 0; i < 4; ++i) v[r][i] = *reinterpret_cast<const float4*>(x + (i * 64 + lane) * 4);
    }
#pragma unroll
    for (int r = 0; r < 2; ++r) {
#pragma unroll
      for (int i = 0; i < 4; ++i) ss[r] += v[r][i].x * v[r][i].x + v[r][i].y * v[r][i].y + v[r][i].z * v[r][i].z + v[r][i].w * v[r][i].w;
    }
#pragma unroll
    for (int o = 32; o >= 1; o >>= 1) { ss[0] += __shfl_xor(ss[0], o); ss[1] += __shfl_xor(ss[1], o); }
#pragma unroll
    for (int r = 0; r < 2; ++r) {
      const float rstd = rsqrtf(ss[r] * (1.f / 1024.f) + EPSV);
#pragma unroll
      for (int i = 0; i < 4; ++i) {
        const int c = (i * 64 + lane) * 4;
        uint2 o2;
        o2.x = pack2(v[r][i].x * rstd * gg[i].x, v[r][i].y * rstd * gg[i].y);
        o2.y = pack2(v[r][i].z * rstd * gg[i].z, v[r][i].w * rstd * gg[i].w);
        *reinterpret_cast<uint2*>(p.h + (long)(row + r) * 1024 + c) = o2;
      }
    }
  }
}

__device__ __forceinline__ void item_conv(const Params& p, int l, int item) {
  const float* cw = p.conv_w + l * 3 * 512;
  for (int e = threadIdx.x; e < 128 * 64; e += NTHR) {
    int tok = item * 128 + (e >> 6), c = (e & 63) * 8;
    int t, b; bool samp = tok >= NP;
    if (!samp) { t = tok & 2047; b = tok >> 11; } else { int ts = tok - NP; t = ts & 15; b = ts >> 4; }
    float y[8];
#pragma unroll
    for (int i = 0; i < 8; ++i) y[i] = 0.f;
#pragma unroll
    for (int j = 0; j < 3; ++j) {
      int pi = t + j;
      float f[8];
      if (pi >= 2) {
        uint4 raw = *reinterpret_cast<const uint4*>(p.u + (long)(tok - 2 + j) * 512 + c);
        unsigned w[4] = {raw.x, raw.y, raw.z, raw.w};
#pragma unroll
        for (int i = 0; i < 4; ++i) { f[2 * i] = __uint_as_float(w[i] << 16); f[2 * i + 1] = __uint_as_float(w[i] & 0xffff0000u); }
      } else if (samp) {
        const float* ps = p.cconv + ((long)(l * 16 + b) * 2 + pi) * 512 + c;
#pragma unroll
        for (int i = 0; i < 8; ++i) f[i] = ps[i];
      } else {
#pragma unroll
        for (int i = 0; i < 8; ++i) f[i] = 0.f;
      }
#pragma unroll
      for (int i = 0; i < 8; ++i) y[i] += f[i] * cw[j * 512 + c + i];
    }
    uint4 graw = *reinterpret_cast<const uint4*>(p.gza + (long)tok * 512 + c);
    unsigned gw[4] = {graw.x, graw.y, graw.z, graw.w};
    uint4 o;
    unsigned ow[4];
#pragma unroll
    for (int i = 0; i < 4; ++i) {
      float g0 = __uint_as_float(gw[i] << 16), g1 = __uint_as_float(gw[i] & 0xffff0000u);
      ow[i] = pack2(g0 * y[2 * i], g1 * y[2 * i + 1]);
    }
    o.x = ow[0]; o.y = ow[1]; o.z = ow[2]; o.w = ow[3];
    *reinterpret_cast<uint4*>(p.gza + (long)tok * 512 + c) = o;
  }
}

#define HQS 0
#define HKS 17408
#define HKT 34816
#define HVT 53248
#define HPS 71680
#define HSP 80896
#define HTOT 115712
#define HER 117760
#define HEL 118272
#define HSSQ 118784
__device__ __forceinline__ void item_hgrn(const Params& p, int l, int sidx) {
  const int tid = otid(), wid = __builtin_amdgcn_readfirstlane(tid >> 6), lane = tid & 63, fr = lane & 15, fq = lane >> 4;
  const bool samp = sidx >= 128;
  int b, hh, T, tok0, nchunks;
  if (!samp) { b = sidx >> 2; hh = sidx & 3; T = 2048; tok0 = b * 2048; nchunks = 32; }
  else { int s = sidx - 128; b = s >> 2; hh = s & 3; T = 16; tok0 = NP + b * 16; nchunks = 1; }
  u16* Qs = reinterpret_cast<u16*>(smem + HQS);
  u16* Ks = reinterpret_cast<u16*>(smem + HKS);
  u16* KTs = reinterpret_cast<u16*>(smem + HKT);
  u16* VTs = reinterpret_cast<u16*>(smem + HVT);
  u16* Ps = reinterpret_cast<u16*>(smem + HPS);
  u16* SpT = reinterpret_cast<u16*>(smem + HSP);
  float* tot = reinterpret_cast<float*>(smem + HTOT);
  float* er = reinterpret_cast<float*>(smem + HER);
  float* el = reinterpret_cast<float*>(smem + HEL);
  float* ssq = reinterpret_cast<float*>(smem + HSSQ);

  f32x4 S[8];
  float* Sout = p.out + (samp ? OFF_HGS + ((long)(l * 16 + b) * 4 + hh) * 16384 : OFF_HGP + ((long)(l * 32 + b) * 4 + hh) * 16384);
  if (samp) {
    const float* S0 = p.shg + ((long)(l * 16 + b) * 4 + hh) * 16384;
#pragma unroll
    for (int n = 0; n < 8; ++n)
#pragma unroll
      for (int j = 0; j < 4; ++j) S[n][j] = S0[(16 * wid + fq * 4 + j) * 128 + n * 16 + fr];
  } else {
#pragma unroll
    for (int n = 0; n < 8; ++n) S[n] = f32x4{0.f, 0.f, 0.f, 0.f};
  }
  const float* hg = p.hg_g + l * 128;
  const int c = tid & 127, qd = wid >> 1;
  float hgv[4];
#pragma unroll
  for (int n = 0; n < 4; ++n) hgv[n] = hg[(wid >> 2) * 64 + n * 16 + fr];

  float lf[16]; unsigned qraw[16]; uint4 vraw[2];
#define HG_LOAD_CHUNK(CH) do { \
    const int t0_ = (CH) * 64; \
    _Pragma("unroll") for (int i = 0; i < 16; ++i) { \
      const int t_ = t0_ + qd * 16 + i; \
      const long rb_ = (long)(tok0 + (t_ < T ? t_ : T - 1)) * 512 + hh * 128 + c; \
      lf[i] = p.logf[rb_]; qraw[i] = p.hq[rb_]; } \
    _Pragma("unroll") for (int i = 0; i < 2; ++i) { \
      const int e = tid + i * NTHR, s = e >> 4, dv0 = (e & 15) * 8; \
      vraw[i] = *reinterpret_cast<const uint4*>(p.hv + (long)(tok0 + (t0_ + s < T ? t0_ + s : T - 1)) * 512 + hh * 128 + dv0); } } while (0)
  HG_LOAD_CHUNK(0);

  for (int ch = 0; ch < nchunks; ++ch) {
    const int t0 = ch * 64;
    {
      float run = 0.f;
#pragma unroll
      for (int i = 0; i < 16; ++i) { if (t0 + qd * 16 + i >= T) { lf[i] = 0.f; qraw[i] = 0u; } run += lf[i]; }
      tot[qd * 128 + c] = run;
    }
#pragma unroll
    for (int i = 0; i < 2; ++i) {
      int e = tid + i * NTHR, s = e >> 4, dv0 = (e & 15) * 8;
      unsigned w[4] = {vraw[i].x, vraw[i].y, vraw[i].z, vraw[i].w};
      if (t0 + s >= T) { w[0] = 0u; w[1] = 0u; w[2] = 0u; w[3] = 0u; }
#pragma unroll
      for (int k = 0; k < 4; ++k) {
        VTs[(dv0 + 2 * k) * 72 + s] = (u16)(w[k] & 0xffffu);
        VTs[(dv0 + 2 * k + 1) * 72 + s] = (u16)(w[k] >> 16);
      }
    }
    __syncthreads();
    {
      float t0v = tot[c], t1v = tot[128 + c], t2v = tot[256 + c], t3v = tot[384 + c];
      float r = t0v + t1v;
      float e = (qd == 0 ? 0.f : qd == 1 ? t0v : qd == 2 ? r : r + t2v) - r;
      if (qd == 0) er[c] = fexp(fmaxf(r, -80.f));
      if (qd == 1) el[c] = fexp(fmaxf(t2v + t3v, -80.f));
      unsigned kpk[8];
#pragma unroll
      for (int i = 0; i < 16; ++i) {
        int tl = qd * 16 + i;
        float lfv = lf[i], qv = __uint_as_float(qraw[i] << 16);
        float kin = (t0 + tl < T) ? (1.f - fexp(lfv)) : 0.f;
        e += lfv;
        float eq = fexp(fminf(fmaxf(e, -80.f), 80.f));
        float ek = fexp(fminf(fmaxf(-e, -80.f), 80.f));
        u16 qb = f2bf(qv * eq), kb = f2bf(kin * ek);
        Qs[tl * 136 + c] = qb; Ks[tl * 136 + c] = kb;
        if (i & 1) kpk[i >> 1] |= ((unsigned)kb) << 16; else kpk[i >> 1] = kb;
      }
      *reinterpret_cast<uint4*>(KTs + c * 72 + qd * 16) = make_uint4(kpk[0], kpk[1], kpk[2], kpk[3]);
      *reinterpret_cast<uint4*>(KTs + c * 72 + qd * 16 + 8) = make_uint4(kpk[4], kpk[5], kpk[6], kpk[7]);
    }
    __syncthreads();
    if (ch + 1 < nchunks) HG_LOAD_CHUNK(ch + 1);
    unsigned gzr[4][4];
    {
      const int tt_ = wid & 3, dvh_ = wid >> 2;
#pragma unroll
      for (int j = 0; j < 4; ++j)
#pragma unroll
        for (int n = 0; n < 4; ++n) {
          int tl = tt_ * 16 + fq * 4 + j;
          int tr = t0 + tl < T ? t0 + tl : T - 1;
          gzr[j][n] = p.gzb[(long)(tok0 + tr) * 512 + hh * 128 + dvh_ * 64 + n * 16 + fr];
        }
    }
    {
      float e4[4];
#pragma unroll
      for (int j = 0; j < 4; ++j) e4[j] = er[16 * wid + fq * 4 + j];
#pragma unroll
      for (int n = 0; n < 8; ++n) {
#pragma unroll
        for (int j = 0; j < 4; ++j) S[n][j] *= e4[j];
        uint2 o2; o2.x = pack2(S[n][0], S[n][1]); o2.y = pack2(S[n][2], S[n][3]);
        *reinterpret_cast<uint2*>(SpT + (n * 16 + fr) * 136 + 16 * wid + fq * 4) = o2;
      }
    }
    {
      const int tt = wid >> 1;
#pragma unroll
      for (int q2 = 0; q2 < 2; ++q2) {
        const int st = 2 * (wid & 1) + q2;
        f32x4 pa = f32x4{0.f, 0.f, 0.f, 0.f};
        if (st <= tt) {
#pragma unroll
          for (int ks = 0; ks < 4; ++ks) {
            bf16x8 a = *reinterpret_cast<const bf16x8*>(Qs + (tt * 16 + fr) * 136 + ks * 32 + fq * 8);
            bf16x8 bb = *reinterpret_cast<const bf16x8*>(Ks + (st * 16 + fr) * 136 + ks * 32 + fq * 8);
            pa = __builtin_amdgcn_mfma_f32_16x16x32_bf16(a, bb, pa, 0, 0, 0);
          }
        }
#pragma unroll
        for (int j = 0; j < 4; ++j) {
          int trow = tt * 16 + fq * 4 + j, scol = st * 16 + fr;
          float v = (scol <= trow) ? pa[j] : 0.f;
          Ps[trow * 72 + scol] = f2bf(v);
        }
      }
    }
    __syncthreads();
    f32x4 oacc[4];
    const int tt = wid & 3, dvh = wid >> 2;
    {
#pragma unroll
      for (int n = 0; n < 4; ++n) oacc[n] = f32x4{0.f, 0.f, 0.f, 0.f};
#pragma unroll
      for (int ks = 0; ks < 2; ++ks) {
        bf16x8 a = *reinterpret_cast<const bf16x8*>(Ps + (tt * 16 + fr) * 72 + ks * 32 + fq * 8);
#pragma unroll
        for (int n = 0; n < 4; ++n) {
          bf16x8 bb = *reinterpret_cast<const bf16x8*>(VTs + (dvh * 64 + n * 16 + fr) * 72 + ks * 32 + fq * 8);
          oacc[n] = __builtin_amdgcn_mfma_f32_16x16x32_bf16(a, bb, oacc[n], 0, 0, 0);
        }
      }
#pragma unroll
      for (int ks = 0; ks < 4; ++ks) {
        bf16x8 a = *reinterpret_cast<const bf16x8*>(Qs + (tt * 16 + fr) * 136 + ks * 32 + fq * 8);
#pragma unroll
        for (int n = 0; n < 4; ++n) {
          bf16x8 bb = *reinterpret_cast<const bf16x8*>(SpT + (dvh * 64 + n * 16 + fr) * 136 + ks * 32 + fq * 8);
          oacc[n] = __builtin_amdgcn_mfma_f32_16x16x32_bf16(a, bb, oacc[n], 0, 0, 0);
        }
      }
#pragma unroll
      for (int j = 0; j < 4; ++j) {
        float ss = 0.f;
#pragma unroll
        for (int n = 0; n < 4; ++n) ss += oacc[n][j] * oacc[n][j];
        ss += __shfl_xor(ss, 1); ss += __shfl_xor(ss, 2); ss += __shfl_xor(ss, 4); ss += __shfl_xor(ss, 8);
        if (fr == 0) ssq[dvh * 64 + tt * 16 + fq * 4 + j] = ss;
      }
    }
    {
#pragma unroll
      for (int ks = 0; ks < 2; ++ks) {
        bf16x8 a = *reinterpret_cast<const bf16x8*>(KTs + (16 * wid + fr) * 72 + ks * 32 + fq * 8);
#pragma unroll
        for (int n = 0; n < 8; ++n) {
          bf16x8 bb = *reinterpret_cast<const bf16x8*>(VTs + (n * 16 + fr) * 72 + ks * 32 + fq * 8);
          S[n] = __builtin_amdgcn_mfma_f32_16x16x32_bf16(a, bb, S[n], 0, 0, 0);
        }
      }
      float e4[4];
#pragma unroll
      for (int j = 0; j < 4; ++j) e4[j] = el[16 * wid + fq * 4 + j];
#pragma unroll
      for (int n = 0; n < 8; ++n)
#pragma unroll
        for (int j = 0; j < 4; ++j) S[n][j] *= e4[j];
    }
    __syncthreads();
#pragma unroll
    for (int j = 0; j < 4; ++j) {
      int tl = tt * 16 + fq * 4 + j;
      if (t0 + tl < T) {
        float ss = ssq[tl] + ssq[64 + tl];
        float rstd = rsqrtf(ss * (1.f / 128.f) + EPSV);
#pragma unroll
        for (int n = 0; n < 4; ++n) {
          int dv = dvh * 64 + n * 16 + fr;
          long idx = (long)(tok0 + t0 + tl) * 512 + hh * 128 + dv;
          float g = __uint_as_float(gzr[j][n] << 16);
          p.gzb[idx] = f2bf(oacc[n][j] * rstd * hgv[n] * g);
        }
      }
    }
  }
#pragma unroll
  for (int n = 0; n < 8; ++n)
#pragma unroll
    for (int j = 0; j < 4; ++j) Sout[(16 * wid + fq * 4 + j) * 128 + n * 16 + fr] = S[n][j];
  __syncthreads();
#undef HG_LOAD_CHUNK
}

#define AKS 0
#define AVT 9216
__device__ __forceinline__ void item_attn(const Params& p, int l, int aidx) {
  const int tid = otid(), wid = __builtin_amdgcn_readfirstlane(tid >> 6), lane = tid & 63, fr = lane & 15, fq = lane >> 4;
  const bool samp = aidx >= 2048;
  int b, hd, nq, qpos0, ntiles; long tokq0;
  const float *kbase, *vbase, *kcache = nullptr, *vcache = nullptr;
  if (!samp) {
    int qb = 7 - (aidx >> 8); int r = aidx & 255; b = r >> 3; hd = r & 7;
    nq = 256; qpos0 = qb * 256; tokq0 = (long)b * 2048 + qpos0; ntiles = qb * 4 + 4;
    kbase = p.out + OFF_KP + ((long)l * 65536 + (long)b * 2048) * 512 + hd * 64;
    vbase = p.out + OFF_VP + ((long)l * 65536 + (long)b * 2048) * 512 + hd * 64;
  } else {
    int r = aidx - 2048; b = r >> 3; hd = r & 7;
    nq = 16; qpos0 = 1024; tokq0 = NP + (long)b * 16; ntiles = 17;
    kbase = p.out + OFF_KS + ((long)l * 256 + (long)b * 16) * 512 + hd * 64;
    vbase = p.out + OFF_VS + ((long)l * 256 + (long)b * 16) * 512 + hd * 64;
    kcache = p.ck + ((long)(l * 16 + b) * 1024) * 512 + hd * 64;
    vcache = p.cv + ((long)(l * 16 + b) * 1024) * 512 + hd * 64;
  }
  u16* Ks = reinterpret_cast<u16*>(smem + AKS);
  u16* VT = reinterpret_cast<u16*>(smem + AVT);

  bf16x8 qf[2][2];
  bool rowv[2];
#pragma unroll
  for (int n = 0; n < 2; ++n) {
    int row = 32 * wid + 16 * n + fr;
    rowv[n] = row < nq;
#pragma unroll
    for (int ks = 0; ks < 2; ++ks) {
      bf16x8 z = {0, 0, 0, 0, 0, 0, 0, 0};
      if (rowv[n]) z = *reinterpret_cast<const bf16x8*>(p.sq + (tokq0 + row) * 512 + hd * 64 + ks * 32 + fq * 8);
      qf[n][ks] = z;
    }
  }
  const bool wave_has_rows = (32 * wid) < nq;
  f32x4 oacc[4][2];
#pragma unroll
  for (int md = 0; md < 4; ++md)
#pragma unroll
    for (int n = 0; n < 2; ++n) oacc[md][n] = f32x4{0.f, 0.f, 0.f, 0.f};
  float carry[2] = {1.f, 1.f};
  const int wave_qmax = qpos0 + 32 * wid + 31;

  float4 kreg[2][2]; float vreg[2][8];
#define ATT_LOAD_TILE(KT, S) do { \
    _Pragma("unroll") for (int i = 0; i < 2; ++i) { \
      const int e = tid + i * NTHR, key = e >> 4, d0 = (e & 15) * 4, pos = (KT) * 64 + key; \
      const float* kp_ = kbase + (long)pos * 512; \
      if (samp) { const int pc_ = pos < 1039 ? pos : 1039; \
        kp_ = (pos < 1024) ? kcache + (long)pc_ * 512 : kbase + (long)(pc_ - 1024) * 512; } \
      kreg[S][i] = *reinterpret_cast<const float4*>(kp_ + d0); } \
    _Pragma("unroll") for (int i = 0; i < 8; ++i) { \
      const int pos = (KT) * 64 + 8 * wid + i; \
      const float* vp_ = vbase + (long)pos * 512; \
      if (samp) { const int pc_ = pos < 1039 ? pos : 1039; \
        vp_ = (pos < 1024) ? vcache + (long)pc_ * 512 : vbase + (long)(pc_ - 1024) * 512; } \
      vreg[S][i] = vp_[lane]; } } while (0)
  ATT_LOAD_TILE(ntiles - 1, 0);
  if (ntiles > 1) ATT_LOAD_TILE(ntiles - 2, 1);
  bool wave_done = !wave_has_rows;

  bool all_done = false;
  for (int kt0 = ntiles - 1; kt0 >= 0 && !all_done; kt0 -= 2) {
#pragma unroll
  for (int hs = 0; hs < 2; ++hs) {
    const int kt = kt0 - hs;
    if (kt < 0 || all_done) break;
#pragma unroll
    for (int i = 0; i < 2; ++i) {
      const int e = tid + i * NTHR, key = e >> 4, d0 = (e & 15) * 4;
      if (samp && kt * 64 + key >= 1040) kreg[hs][i] = make_float4(0.f, 0.f, 0.f, 0.f);
      uint2 k2; k2.x = pack2(kreg[hs][i].x, kreg[hs][i].y); k2.y = pack2(kreg[hs][i].z, kreg[hs][i].w);
      *reinterpret_cast<uint2*>(Ks + key * 72 + d0) = k2;
    }
    {
      if (samp) {
#pragma unroll
        for (int i = 0; i < 8; ++i) if (kt * 64 + 8 * wid + i >= 1040) vreg[hs][i] = 0.f;
      }
      uint4 v4; v4.x = pack2(vreg[hs][0], vreg[hs][1]); v4.y = pack2(vreg[hs][2], vreg[hs][3]); v4.z = pack2(vreg[hs][4], vreg[hs][5]); v4.w = pack2(vreg[hs][6], vreg[hs][7]);
      *reinterpret_cast<uint4*>(VT + lane * 72 + 8 * wid) = v4;
    }
    __syncthreads();
    if (kt > 1) ATT_LOAD_TILE(kt - 2, hs);
    if (!wave_done && kt * 64 < wave_qmax) {
      f32x4 z[4][2];
#pragma unroll
      for (int m = 0; m < 4; ++m) {
        bf16x8 a0 = *reinterpret_cast<const bf16x8*>(Ks + (m * 16 + fr) * 72 + fq * 8);
        bf16x8 a1 = *reinterpret_cast<const bf16x8*>(Ks + (m * 16 + fr) * 72 + 32 + fq * 8);
#pragma unroll
        for (int n = 0; n < 2; ++n) {
          f32x4 zz = f32x4{0.f, 0.f, 0.f, 0.f};
          zz = __builtin_amdgcn_mfma_f32_16x16x32_bf16(a0, qf[n][0], zz, 0, 0, 0);
          zz = __builtin_amdgcn_mfma_f32_16x16x32_bf16(a1, qf[n][1], zz, 0, 0, 0);
          z[m][n] = zz;
        }
      }
      unsigned pk[4][2][2];
#pragma unroll
      for (int n = 0; n < 2; ++n) {
        const int qpos = qpos0 + 32 * wid + 16 * n + fr;
        float wgt[4][4], excl[4][4], later[4], TT[4];
#pragma unroll
        for (int m = 0; m < 4; ++m) {
          float f[4];
#pragma unroll
          for (int j = 0; j < 4; ++j) {
            const int kpos = kt * 64 + m * 16 + fq * 4 + j;
            const float e = fexp(fminf(-z[m][n][j], 80.f));
            const float sg = __builtin_amdgcn_rcpf(1.f + e);
            const bool ok = kpos < qpos;
            wgt[m][j] = ok ? sg : 0.f;
            f[j] = ok ? e * sg : 1.f;
          }
          excl[m][3] = 1.f; excl[m][2] = f[3]; excl[m][1] = f[3] * f[2]; excl[m][0] = excl[m][1] * f[1];
          const float G = excl[m][0] * f[0];
          const float g1 = __shfl_xor(G, 16), g2 = __shfl_xor(G, 32), g3 = __shfl_xor(G, 48);
          later[m] = ((fq ^ 1) > fq ? g1 : 1.f) * ((fq ^ 2) > fq ? g2 : 1.f) * ((fq ^ 3) > fq ? g3 : 1.f);
          TT[m] = (G * g1) * (g2 * g3);
        }
        float lm[4]; lm[3] = carry[n]; lm[2] = lm[3] * TT[3]; lm[1] = lm[2] * TT[2]; lm[0] = lm[1] * TT[1];
#pragma unroll
        for (int m = 0; m < 4; ++m) {
          const float base = later[m] * lm[m];
          float pv[4];
#pragma unroll
          for (int j = 0; j < 4; ++j) pv[j] = wgt[m][j] * excl[m][j] * base;
          pk[m][n][0] = pack2(pv[0], pv[1]); pk[m][n][1] = pack2(pv[2], pv[3]);
        }
        carry[n] = lm[0] * TT[0];
      }
#pragma unroll
      for (int kk = 0; kk < 2; ++kk) {
        bf16x8 pb[2];
#pragma unroll
        for (int n = 0; n < 2; ++n) {
          union { unsigned u[4]; bf16x8 v; } cv;
          cv.u[0] = pk[2 * kk][n][0]; cv.u[1] = pk[2 * kk][n][1]; cv.u[2] = pk[2 * kk + 1][n][0]; cv.u[3] = pk[2 * kk + 1][n][1];
          pb[n] = cv.v;
        }
#pragma unroll
        for (int md = 0; md < 4; ++md) {
          union { uint2 h[2]; bf16x8 v; } av;
          av.h[0] = *reinterpret_cast<const uint2*>(VT + (md * 16 + fr) * 72 + kk * 32 + fq * 4);
          av.h[1] = *reinterpret_cast<const uint2*>(VT + (md * 16 + fr) * 72 + kk * 32 + 16 + fq * 4);
#pragma unroll
          for (int n = 0; n < 2; ++n) oacc[md][n] = __builtin_amdgcn_mfma_f32_16x16x32_bf16(av.v, pb[n], oacc[md][n], 0, 0, 0);
        }
      }
      wave_done = __all(((carry[0] < 1e-36f) || !rowv[0]) && ((carry[1] < 1e-36f) || !rowv[1]));
    }
    if (__syncthreads_and(wave_done ? 1 : 0)) all_done = true;
  }
  }
#undef ATT_LOAD_TILE
  {
    uint2 gz[2][4];
#pragma unroll
    for (int n = 0; n < 2; ++n) {
      int row = 32 * wid + 16 * n + fr; if (row >= nq) row = nq - 1;
#pragma unroll
      for (int md = 0; md < 4; ++md) gz[n][md] = *reinterpret_cast<const uint2*>(p.gzc + (tokq0 + row) * 512 + hd * 64 + md * 16 + fq * 4);
    }
#pragma unroll
    for (int n = 0; n < 2; ++n) {
      const int row = 32 * wid + 16 * n + fr;
#pragma unroll
      for (int md = 0; md < 4; ++md) {
        const uint2 g2 = gz[n][md];
        float g0 = __uint_as_float(g2.x << 16), g1 = __uint_as_float(g2.x & 0xffff0000u);
        float g2f = __uint_as_float(g2.y << 16), g3 = __uint_as_float(g2.y & 0xffff0000u);
        uint2 o2; o2.x = pack2(oacc[md][n][0] * g0, oacc[md][n][1] * g1); o2.y = pack2(oacc[md][n][2] * g2f, oacc[md][n][3] * g3);
        if (row < nq) *reinterpret_cast<uint2*>(p.sq + (tokq0 + row) * 512 + hd * 64 + md * 16 + fq * 4) = o2;
      }
    }
  }
}

#ifndef LAS
#define LAS __attribute__((address_space(3)))
#endif
__device__ __forceinline__ int lds_byte(int r, int c) { const int st = (r >> 4) * 2 + (c >> 5), rr = r & 15, cc = c & 31, ob = rr * 64 + cc * 2; return st * 1024 + (ob ^ (((ob >> 9) & 1) << 5)); }
__device__ __forceinline__ void stage_rc(int b, int& R, int& C) { const int st = b / 1024, sb = b % 1024, swz = sb ^ (((sb >> 9) & 1) << 5); R = (st >> 1) * 16 + swz / 64; C = (st & 1) * 32 + (swz % 64) / 2; }

struct GUnit { const char* A; const char* B; int ld; int nt; int pm, pn, sub; };

__device__ __forceinline__ bool gemm_unit(const Params& p, int l, int kind, int single, int i, GUnit& u) {
  const int nN = (kind == 1) ? 24 : 4, nM = (kind == 1) ? 257 : 256, nwg = nM * nN, nsub = (kind == 3) ? 6 : 1;
  const int G = gridDim.x, c = blockIdx.x;
  const int ti = i / nsub; u.sub = i - ti * nsub;
  const long L = (single >= 0) ? (ti == 0 ? 0 : nwg) : (long)ti * G + c; if (L >= nwg) return false;
  int wgid = (int)L; { const int q = nwg / 8, r = nwg % 8, xcd = wgid % 8, off = wgid / 8; wgid = (xcd < r ? xcd * (q + 1) : r * (q + 1) + (xcd - r) * q) + off; }
  const int nig = 8 * nN, gid = wgid / nig, fm = gid * 8, gsz = (nM - fm) < 8 ? (nM - fm) : 8;
  u.pm = fm + ((wgid % nig) % gsz); u.pn = (wgid % nig) / gsz;
  if (single >= 0) { u.pm = 256; u.pn = single; }
  const u16* Win = p.wt_in + (long)l * 9216 * 1024;
  if (kind == 1) { u.A = (const char*)(p.h + (long)u.pm * 256 * 1024); u.B = (const char*)(Win + (long)u.pn * 256 * 1024); u.ld = 1024; }
  else if (kind == 4) { u.A = (const char*)(p.m + (long)u.pm * 256 * 1024); u.B = (const char*)(p.wt_out + (long)l * 1024 * 1024 + (long)u.pn * 256 * 1024); u.ld = 1024; }
  else {
    const int br = u.sub >> 1;
    if (u.sub & 1) { u.A = (const char*)(p.h + (long)u.pm * 256 * 1024); u.B = (const char*)(Win + (long)(6144 + br * 1024 + u.pn * 256) * 1024); u.ld = 1024; }
    else {
      const u16* O = (br == 0 ? p.gza : br == 1 ? p.gzb : p.sq);
      u.A = (const char*)(O + (long)u.pm * 256 * 512); u.B = (const char*)(p.wt_br + (long)(l * 3 + br) * 1024 * 512 + (long)u.pn * 256 * 512); u.ld = 512;
    }
  }
  u.nt = u.ld >> 6;
  return true;
}

__device__ __forceinline__ void gemm_epi(const Params& p, int l, int kind, const GUnit& u, f32x4 (&acc)[2][2][4][2]) {
  const int tid = otid(), wid = __builtin_amdgcn_readfirstlane(tid >> 6), lane = tid & 63, wr = wid >> 2, wc = wid & 3, fr = lane & 15, fq = lane >> 4;
  int row0 = u.pm * 256 + wr * 64 + fr;
  asm volatile("" : "+v"(row0));
  if (kind == 4) {
    const int col0 = u.pn * 256 + wc * 32 + 4 * fq;
    const float* xbase = (l == 0) ? (u.pm < 256 ? p.xp : p.xs - (long)NP * 1024) : p.out;
#pragma unroll
    for (int ai = 0; ai < 2; ++ai) {
      f32x4 xv[4][2][2];
#pragma unroll
      for (int m = 0; m < 4; ++m) {
        const float* xr = xbase + (long)(row0 + ai * 128 + m * 16) * 1024 + col0;
#pragma unroll
        for (int bj = 0; bj < 2; ++bj)
#pragma unroll
          for (int n = 0; n < 2; ++n) xv[m][bj][n] = *reinterpret_cast<const f32x4*>(xr + bj * 128 + n * 16);
      }
#pragma unroll
      for (int m = 0; m < 4; ++m) {
        float* yr = p.out + (long)(row0 + ai * 128 + m * 16) * 1024 + col0;
#pragma unroll
        for (int bj = 0; bj < 2; ++bj)
#pragma unroll
          for (int n = 0; n < 2; ++n) *reinterpret_cast<f32x4*>(yr + bj * 128 + n * 16) = xv[m][bj][n] + acc[ai][bj][m][n];
      }
      __builtin_amdgcn_sched_barrier(0);
    }
  } else if (kind == 3) {
    char* gbu = p.gbuf + (long)blockIdx.x * 131072;
    char* mbu = p.mbuf + (long)blockIdx.x * 131072;
    unsigned lo16 = (unsigned)tid * 16u;
    asm volatile("" : "+v"(lo16));
    const int br = u.sub >> 1;
    const char* mls = (br > 0) ? mbu : gbu;
    if (!(u.sub & 1)) {
#pragma unroll
      for (int ai = 0; ai < 2; ++ai)
#pragma unroll
        for (int bj = 0; bj < 2; ++bj)
#pragma unroll
          for (int m = 0; m < 4; ++m) {
            const int q = (ai * 2 + bj) * 4 + m;
            const f32x4 a0 = acc[ai][bj][m][0], a1 = acc[ai][bj][m][1];
            uint4 o;
            o.x = pack2(a0[0], a0[1]); o.y = pack2(a0[2], a0[3]); o.z = pack2(a1[0], a1[1]); o.w = pack2(a1[2], a1[3]);
            *reinterpret_cast<uint4*>((gbu + q * 8192) + lo16) = o;
          }
    } else {
#pragma unroll
      for (int ai = 0; ai < 2; ++ai) {
        uint4 g[2][4], mm[2][4];
#pragma unroll
        for (int bj = 0; bj < 2; ++bj)
#pragma unroll
          for (int m = 0; m < 4; ++m) {
            const int q = (ai * 2 + bj) * 4 + m;
            g[bj][m] = *reinterpret_cast<const uint4*>((gbu + q * 8192) + lo16);
            mm[bj][m] = *reinterpret_cast<const uint4*>((mls + q * 8192) + lo16);
          }
#pragma unroll
        for (int bj = 0; bj < 2; ++bj)
#pragma unroll
          for (int m = 0; m < 4; ++m) {
            const int q = (ai * 2 + bj) * 4 + m;
            const uint4 yy = g[bj][m]; uint4 mo = mm[bj][m];
            mo.x = (br > 0) ? mo.x : 0u; mo.y = (br > 0) ? mo.y : 0u; mo.z = (br > 0) ? mo.z : 0u; mo.w = (br > 0) ? mo.w : 0u;
            f32x4 s0 = acc[ai][bj][m][0], s1 = acc[ai][bj][m][1];
#pragma unroll
            for (int j = 0; j < 4; ++j) { s0[j] = sigmoidf_(s0[j]); s1[j] = sigmoidf_(s1[j]); }
            uint4 o;
            o.x = pack2(__uint_as_float(yy.x << 16) * s0[0] + __uint_as_float(mo.x << 16), __uint_as_float(yy.x & 0xffff0000u) * s0[1] + __uint_as_float(mo.x & 0xffff0000u));
            o.y = pack2(__uint_as_float(yy.y << 16) * s0[2] + __uint_as_float(mo.y << 16), __uint_as_float(yy.y & 0xffff0000u) * s0[3] + __uint_as_float(mo.y & 0xffff0000u));
            o.z = pack2(__uint_as_float(yy.z << 16) * s1[0] + __uint_as_float(mo.z << 16), __uint_as_float(yy.z & 0xffff0000u) * s1[1] + __uint_as_float(mo.z & 0xffff0000u));
            o.w = pack2(__uint_as_float(yy.w << 16) * s1[2] + __uint_as_float(mo.w << 16), __uint_as_float(yy.w & 0xffff0000u) * s1[3] + __uint_as_float(mo.w & 0xffff0000u));
            if (br < 2) *reinterpret_cast<uint4*>((mbu + q * 8192) + lo16) = o;
            mm[bj][m] = o;
          }
        if (br == 2) {
          unsigned mo16 = (unsigned)((row0 - u.pm * 256) * 1024 + (wc * 32 + 8 * fq)) * 2u;
          asm volatile("" : "+v"(mo16));
          char* mrow = (char*)(p.m + (long)u.pm * 256 * 1024 + u.pn * 256);
#pragma unroll
          for (int bj = 0; bj < 2; ++bj)
#pragma unroll
            for (int m = 0; m < 4; ++m)
              *reinterpret_cast<uint4*>((mrow + ((ai * 128 + m * 16) * 1024 + bj * 128) * 2) + mo16) = mm[bj][m];
        }
        __builtin_amdgcn_sched_barrier(0);
      }
    }
  } else {
    const int pn = u.pn;
    if (pn < 8) {
      const int ch = (pn & 3) * 128 + wc * 32 + 8 * fq;
      if (pn < 4) {
#pragma unroll
        for (int ai = 0; ai < 2; ++ai)
#pragma unroll
          for (int m = 0; m < 4; ++m) {
            const int tok = row0 + ai * 128 + m * 16;
            const f32x4 u0 = acc[ai][1][m][0] * acc[ai][0][m][0], u1 = acc[ai][1][m][1] * acc[ai][0][m][1];
            uint4 o; o.x = pack2(u0[0], u0[1]); o.y = pack2(u0[2], u0[3]); o.z = pack2(u1[0], u1[1]); o.w = pack2(u1[2], u1[3]);
            *reinterpret_cast<uint4*>(p.u + (long)tok * 512 + ch) = o;
            if (tok < NP) {
              int tt = tok & 2047, bb = tok >> 11;
              if (tt >= 2046) { float* d = p.out + OFF_CONVP + ((long)(l * 32 + bb) * 2 + (tt - 2046)) * 512 + ch;
                *reinterpret_cast<f32x4*>(d) = u0; *reinterpret_cast<f32x4*>(d + 4) = u1; }
            } else {
              int ts = tok - NP, tt = ts & 15, bb = ts >> 4;
              if (tt >= 14) { float* d = p.out + OFF_CONVS + ((long)(l * 16 + bb) * 2 + (tt - 14)) * 512 + ch;
                *reinterpret_cast<f32x4*>(d) = u0; *reinterpret_cast<f32x4*>(d + 4) = u1; }
            }
          }
      } else {
#pragma unroll
        for (int ai = 0; ai < 2; ++ai)
#pragma unroll
          for (int m = 0; m < 4; ++m) {
            const int tok = row0 + ai * 128 + m * 16;
            const f32x4 b0 = acc[ai][0][m][0], b1 = acc[ai][0][m][1], z0 = acc[ai][1][m][0], z1 = acc[ai][1][m][1];
            uint4 o;
            o.x = pack2(b0[0] * siluf_(z0[0]), b0[1] * siluf_(z0[1])); o.y = pack2(b0[2] * siluf_(z0[2]), b0[3] * siluf_(z0[3]));
            o.z = pack2(b1[0] * siluf_(z1[0]), b1[1] * siluf_(z1[1])); o.w = pack2(b1[2] * siluf_(z1[2]), b1[3] * siluf_(z1[3]));
            *reinterpret_cast<uint4*>(p.gza + (long)tok * 512 + ch) = o;
          }
      }
    } else if (pn < 16) {
      const int seg = (pn - 8) >> 1, cb = ((pn - 8) & 1) * 256 + wc * 32 + 4 * fq;
      if (seg == 1) {
        f32x4 lbv4[2][2];
#pragma unroll
        for (int bj = 0; bj < 2; ++bj)
#pragma unroll
          for (int n = 0; n < 2; ++n) lbv4[bj][n] = *reinterpret_cast<const f32x4*>(p.lbv + l * 512 + cb + bj * 128 + n * 16);
#pragma unroll
        for (int ai = 0; ai < 2; ++ai)
#pragma unroll
          for (int m = 0; m < 4; ++m) {
            float* dst = p.logf + (long)(row0 + ai * 128 + m * 16) * 512 + cb;
#pragma unroll
            for (int bj = 0; bj < 2; ++bj)
#pragma unroll
              for (int n = 0; n < 2; ++n) {
                const f32x4 v = acc[ai][bj][m][n], lb = lbv4[bj][n];
                f32x4 o;
#pragma unroll
                for (int j = 0; j < 4; ++j) o[j] = flog(lb[j] + (1.f - lb[j]) * sigmoidf_(v[j]));
                *reinterpret_cast<f32x4*>(dst + bj * 128 + n * 16) = o;
              }
          }
      } else {
        u16* dbase = (seg == 0) ? p.hq : (seg == 2) ? p.hv : p.gzb;
        const int cbp = ((pn - 8) & 1) * 256 + wc * 32 + 8 * fq;
#pragma unroll
        for (int ai = 0; ai < 2; ++ai)
#pragma unroll
          for (int m = 0; m < 4; ++m) {
            u16* dst = dbase + (long)(row0 + ai * 128 + m * 16) * 512 + cbp;
#pragma unroll
            for (int bj = 0; bj < 2; ++bj) {
              f32x4 v0 = acc[ai][bj][m][0], v1 = acc[ai][bj][m][1];
              if (seg == 3) {
#pragma unroll
                for (int j = 0; j < 4; ++j) { v0[j] = siluf_(v0[j]); v1[j] = siluf_(v1[j]); }
              }
              uint4 o; o.x = pack2(v0[0], v0[1]); o.y = pack2(v0[2], v0[3]); o.z = pack2(v1[0], v1[1]); o.w = pack2(v1[2], v1[3]);
              *reinterpret_cast<uint4*>(dst + bj * 128) = o;
            }
          }
      }
    } else {
      const int seg = (pn - 16) >> 1, head = ((pn - 16) & 1) * 4 + wc;
      const int dl = head * 64 + 4 * fq, dlp = head * 64 + 8 * fq;
      if (seg < 2) {
        const float* gp = (seg == 0) ? p.q_g + l * 64 + 8 * fq : p.k_g + l * 64 + 4 * fq;
        f32x4 g4[2][2];
#pragma unroll
        for (int bj = 0; bj < 2; ++bj)
#pragma unroll
          for (int n = 0; n < 2; ++n) g4[bj][n] = *reinterpret_cast<const f32x4*>(gp + 32 * bj + (seg == 0 ? 4 * n : 16 * n));
        float* kP = p.out + OFF_KP + (long)l * 65536 * 512;
        float* kS = p.out + OFF_KS + (long)l * 256 * 512 - (long)NP * 512;
        float* kb = (u.pm < 256) ? kP : kS;
#pragma unroll
        for (int ai = 0; ai < 2; ++ai)
#pragma unroll
          for (int m = 0; m < 4; ++m) {
            const int tok = row0 + ai * 128 + m * 16;
            float ss = 0.f;
#pragma unroll
            for (int bj = 0; bj < 2; ++bj)
#pragma unroll
              for (int n = 0; n < 2; ++n) { f32x4 v = acc[ai][bj][m][n]; ss += v[0] * v[0] + v[1] * v[1] + v[2] * v[2] + v[3] * v[3]; }
            ss += __shfl_xor(ss, 16); ss += __shfl_xor(ss, 32);
            const float rstd = rsqrtf(ss * (1.f / 64.f) + EPSV) * (seg == 0 ? 0.125f : 1.f);
#pragma unroll
            for (int bj = 0; bj < 2; ++bj) {
              const f32x4 v0 = acc[ai][bj][m][0] * rstd * g4[bj][0], v1 = acc[ai][bj][m][1] * rstd * g4[bj][1];
              if (seg == 1) {
                *reinterpret_cast<f32x4*>(kb + (long)tok * 512 + dl + 32 * bj) = v0;
                *reinterpret_cast<f32x4*>(kb + (long)tok * 512 + dl + 32 * bj + 16) = v1;
              } else {
                uint4 o; o.x = pack2(v0[0], v0[1]); o.y = pack2(v0[2], v0[3]); o.z = pack2(v1[0], v1[1]); o.w = pack2(v1[2], v1[3]);
                *reinterpret_cast<uint4*>(p.sq + (long)tok * 512 + dlp + 32 * bj) = o;
              }
            }
          }
      } else if (seg == 2) {
        float* vP = p.out + OFF_VP + (long)l * 65536 * 512;
        float* vS = p.out + OFF_VS + (long)l * 256 * 512 - (long)NP * 512;
        float* vb = (u.pm < 256) ? vP : vS;
#pragma unroll
        for (int ai = 0; ai < 2; ++ai)
#pragma unroll
          for (int m = 0; m < 4; ++m) {
            float* dst = vb + (long)(row0 + ai * 128 + m * 16) * 512 + dl;
#pragma unroll
            for (int bj = 0; bj < 2; ++bj)
#pragma unroll
              for (int n = 0; n < 2; ++n) *reinterpret_cast<f32x4*>(dst + 32 * bj + 16 * n) = acc[ai][bj][m][n];
          }
      } else {
#pragma unroll
        for (int ai = 0; ai < 2; ++ai)
#pragma unroll
          for (int m = 0; m < 4; ++m) {
            u16* dst = p.gzc + (long)(row0 + ai * 128 + m * 16) * 512 + dlp;
#pragma unroll
            for (int bj = 0; bj < 2; ++bj) {
              f32x4 v0 = acc[ai][bj][m][0], v1 = acc[ai][bj][m][1];
#pragma unroll
              for (int j = 0; j < 4; ++j) { v0[j] = siluf_(v0[j]); v1[j] = siluf_(v1[j]); }
              uint4 o; o.x = pack2(v0[0], v0[1]); o.y = pack2(v0[2], v0[3]); o.z = pack2(v1[0], v1[1]); o.w = pack2(v1[2], v1[3]);
              *reinterpret_cast<uint4*>(dst + 32 * bj) = o;
            }
          }
      }
    }
  }
}

__device__ __forceinline__ void gemm_run(const Params& p, int l, int kind, int single) {
  LAS unsigned char* lds = (LAS unsigned char*)smem;
  const int tid = otid(), wid = __builtin_amdgcn_readfirstlane(tid >> 6), lane = tid & 63, wr = wid >> 2, wc = wid & 3, fr = lane & 15, fq = lane >> 4;
  constexpr int HTB = 128 * 64 * 2;
  int sR[2], sC[2];
#pragma unroll
  for (int i = 0; i < 2; ++i) stage_rc(tid * 16 + i * 8192, sR[i], sC[i]);
  const size_t kstep = 128;
  const unsigned ldsw = (unsigned)wid * 1024u;
  const int aoff = lds_byte(wr * 64 + fr, fq * 8), boff = lds_byte(wc * 32 + fr, fq * 8);
#define G_SA(b, h) (((b) * 2 + (h)) * HTB)
#define G_SB(b, h) ((4 + (b) * 2 + (h)) * HTB)
#define G_STAGE(bufoff, gbase, v0, v1) do { \
    __builtin_amdgcn_global_load_lds((const unsigned*)((const char*)(gbase) + (v0)), (LAS unsigned*)(lds + (bufoff) + ldsw), 16, 0, 0); \
    __builtin_amdgcn_global_load_lds((const unsigned*)((const char*)(gbase) + (v1)), (LAS unsigned*)(lds + (bufoff) + ldsw + 8192), 16, 0, 0); } while (0)
#define G_LDA(dst, b, h) do { _Pragma("unroll") for (int m = 0; m < 4; ++m) _Pragma("unroll") for (int k = 0; k < 2; ++k) dst[m][k] = *(const LAS bf16x8*)(lds + G_SA(b, h) + aoff + m * 2048 + k * 1024); } while (0)
#define G_LDB(dst, b, h) do { _Pragma("unroll") for (int n = 0; n < 2; ++n) _Pragma("unroll") for (int k = 0; k < 2; ++k) dst[n][k] = *(const LAS bf16x8*)(lds + G_SB(b, h) + boff + n * 2048 + k * 1024); } while (0)
#define G_MMA(ai, bj, At, Bt) do { __builtin_amdgcn_s_setprio(1); _Pragma("unroll") for (int m = 0; m < 4; ++m) _Pragma("unroll") for (int n = 0; n < 2; ++n) _Pragma("unroll") for (int k = 0; k < 2; ++k) \
    acc[ai][bj][m][n] = __builtin_amdgcn_mfma_f32_16x16x32_bf16(Bt[n][k], At[m][k], acc[ai][bj][m][n], 0, 0, 0); __builtin_amdgcn_s_setprio(0); } while (0)
#define G_WAIT_V(n) asm volatile("s_waitcnt vmcnt(" #n ")" ::: "memory")
#define G_WAIT_L(n) asm volatile("s_waitcnt lgkmcnt(" #n ")" ::: "memory")
#define G_BAR __builtin_amdgcn_s_barrier()
#define G_SCHED __builtin_amdgcn_sched_barrier(0)
  GUnit cur, nxt; int ui = 0;
  if (!gemm_unit(p, l, kind, single, 0, cur)) return;
  f32x4 acc[2][2][4][2];
#pragma unroll
  for (int a = 0; a < 2; ++a)
#pragma unroll
    for (int b = 0; b < 2; ++b)
#pragma unroll
      for (int m = 0; m < 4; ++m)
#pragma unroll
        for (int n = 0; n < 2; ++n) acc[a][b][m][n] = f32x4{0.f, 0.f, 0.f, 0.f};
  bf16x8 At[4][2], B0[2][2], B1[2][2];
  const char* cA = cur.A; const char* cB = cur.B;
  unsigned vc0 = (unsigned)(sR[0] * cur.ld + sC[0]) * 2u, vc1 = (unsigned)(sR[1] * cur.ld + sC[1]) * 2u;
  size_t hc = (size_t)128 * cur.ld * 2;
  G_STAGE(G_SB(0, 0), cB, vc0, vc1); G_STAGE(G_SA(0, 0), cA, vc0, vc1); G_STAGE(G_SB(0, 1), cB + hc, vc0, vc1); G_STAGE(G_SA(0, 1), cA + hc, vc0, vc1);
  if (wr == 1) G_BAR;
  G_WAIT_V(4); G_BAR;
  G_STAGE(G_SB(1, 0), cB + kstep, vc0, vc1); G_STAGE(G_SA(1, 0), cA + kstep, vc0, vc1); G_STAGE(G_SB(1, 1), cB + hc + kstep, vc0, vc1);
  G_WAIT_V(6); G_BAR;
  for (;;) {
    const bool has_next = gemm_unit(p, l, kind, single, ui + 1, nxt);
    const char* nA = has_next ? nxt.A : cA; const char* nB = has_next ? nxt.B : cB;
    const int nld = has_next ? nxt.ld : cur.ld;
    const unsigned vn0 = (unsigned)(sR[0] * nld + sC[0]) * 2u, vn1 = (unsigned)(sR[1] * nld + sC[1]) * 2u;
    const size_t hn = (size_t)128 * nld * 2;
    const int nt = cur.nt;
    for (int t = 0; t < nt; t += 2) {
      const bool last = (t == nt - 2);
      const char* a1 = cA + (size_t)(t + 1) * kstep;
      const char* a2 = last ? nA : cA + (size_t)(t + 2) * kstep; const char* b2 = last ? nB : cB + (size_t)(t + 2) * kstep;
      const char* a3 = a2 + kstep; const char* b3 = b2 + kstep;
      const unsigned w0 = last ? vn0 : vc0, w1 = last ? vn1 : vc1; const size_t h2 = last ? hn : hc;
      G_LDB(B0, 0, 0); G_SCHED; G_LDA(At, 0, 0); G_STAGE(G_SA(1, 1), a1 + hc, vc0, vc1);
      G_WAIT_L(8); G_BAR; G_WAIT_L(0); G_MMA(0, 0, At, B0); G_BAR; G_SCHED;
      G_LDB(B1, 0, 1); G_STAGE(G_SB(0, 0), b2, w0, w1);
      G_BAR; G_WAIT_L(0); G_MMA(0, 1, At, B1); G_BAR;
      G_LDA(At, 0, 1); G_STAGE(G_SA(0, 0), a2, w0, w1);
      G_BAR; G_WAIT_L(0); G_MMA(1, 0, At, B0); G_BAR; G_SCHED;
      G_STAGE(G_SB(0, 1), b2 + h2, w0, w1);
      G_WAIT_V(6); G_BAR; G_MMA(1, 1, At, B1); G_BAR;
      G_LDB(B0, 1, 0); G_SCHED; G_LDA(At, 1, 0); G_STAGE(G_SA(0, 1), a2 + h2, w0, w1);
      G_WAIT_L(8); G_BAR; G_WAIT_L(0); G_MMA(0, 0, At, B0); G_BAR; G_SCHED;
      G_LDB(B1, 1, 1); G_STAGE(G_SB(1, 0), b3, w0, w1);
      G_BAR; G_WAIT_L(0); G_MMA(0, 1, At, B1); G_BAR;
      G_LDA(At, 1, 1); G_STAGE(G_SA(1, 0), a3, w0, w1);
      G_BAR; G_WAIT_L(0); G_MMA(1, 0, At, B0); G_BAR; G_SCHED;
      G_STAGE(G_SB(1, 1), b3 + h2, w0, w1);
      G_WAIT_V(6); G_BAR; G_MMA(1, 1, At, B1); G_BAR;
    }
    gemm_epi(p, l, kind, cur, acc);
    if (!has_next) break;
#pragma unroll
    for (int a = 0; a < 2; ++a)
#pragma unroll
      for (int b = 0; b < 2; ++b)
#pragma unroll
        for (int m = 0; m < 4; ++m)
#pragma unroll
          for (int n = 0; n < 2; ++n) acc[a][b][m][n] = f32x4{0.f, 0.f, 0.f, 0.f};
    cur = nxt; cA = nA; cB = nB; vc0 = vn0; vc1 = vn1; hc = hn; ++ui;
  }
  G_WAIT_V(0);
  if (wr == 0) G_BAR;
  G_BAR;
#undef G_SA
#undef G_SB
#undef G_STAGE
#undef G_LDA
#undef G_LDB
#undef G_MMA
#undef G_WAIT_V
#undef G_WAIT_L
#undef G_BAR
#undef G_SCHED
}

__device__ __forceinline__ void signal_done(int* cnt) {
  asm volatile("s_waitcnt vmcnt(0)" ::: "memory");
  __syncthreads();
  if (threadIdx.x == 0) {
    __builtin_amdgcn_fence(__ATOMIC_RELEASE, "agent");
    asm volatile("s_waitcnt vmcnt(0)" ::: "memory");
    __hip_atomic_fetch_add(cnt, 1, __ATOMIC_RELAXED, __HIP_MEMORY_SCOPE_AGENT);
  }
}
__device__ __forceinline__ void wait_for(int* cnt, int need) {
  if (threadIdx.x == 0) {
    unsigned spins = 0;
    while (__hip_atomic_load(cnt, __ATOMIC_RELAXED, __HIP_MEMORY_SCOPE_AGENT) < need) { __builtin_amdgcn_s_sleep(8); if (++spins > (1u << 22)) break; }
    __builtin_amdgcn_fence(__ATOMIC_ACQUIRE, "agent");
    asm volatile("s_waitcnt vmcnt(0)" ::: "memory");
  }
  __syncthreads();
}
#define Q_HGP 128
#define Q_HGS (Q_HGP + 64)
#define Q_ATS (Q_HGS + 128)
#define Q_CVS (Q_ATS + 2)
#define Q_P3S (Q_CVS + 4)
#define Q_P4S (Q_P3S + 4)
#define Q_ATP (Q_P4S + 2048)
#define Q_CVP (Q_ATP + 512)
__device__ __forceinline__ void phase_p2(const Params& p, int l) {
  int* s_item = reinterpret_cast<int*>(smem + LDS_BYTES - 16);
  int* cnt_s = p.ctr + 2 + l; int* cnt_m = p.ctr + 4 + l;
  while (true) {
    if (threadIdx.x == 0) *s_item = atomicAdd(p.ctr + l, 1);
    __syncthreads();
    const int item = *s_item;
    __syncthreads();
    if (item >= Q_CVP) break;
    int kind, sub;
    if (item < Q_HGP) { kind = 0; sub = item; }
    else if (item < Q_HGS) { kind = 0; sub = 128 + item - Q_HGP; }
    else if (item < Q_ATS) { kind = 1; sub = 2048 + item - Q_HGS; }
    else if (item < Q_CVS) { kind = 2; sub = 512 + item - Q_ATS; }
    else if (item < Q_P3S) { kind = 3; sub = item - Q_CVS; }
    else if (item < Q_P4S) { kind = 4; sub = item - Q_P3S; }
    else if (item < Q_ATP) { kind = 1; sub = item - Q_P4S; }
    else { kind = 2; sub = item - Q_ATP; }
    if (kind == 0) item_hgrn(p, l, sub);
    else if (kind == 1) item_attn(p, l, sub);
    else if (kind == 2) item_conv(p, l, sub);
    else if (kind == 3) { wait_for(cnt_s, 64 + 128 + 2); gemm_run(p, l, 3, sub); }
    else { wait_for(cnt_m, 4); gemm_run(p, l, 4, sub); }
    if (item >= Q_HGP && item < Q_CVS) signal_done(cnt_s);
    else if (kind == 3) signal_done(cnt_m);
    __syncthreads();
  }
}

__global__ void __launch_bounds__(NTHR) fwd_mega(Params p, int ph_lo, int ph_hi) {
  cg::grid_group grid = cg::this_grid();
  if (threadIdx.x < 2) *reinterpret_cast<volatile unsigned*>(smem + LDS_BYTES - 32 + 4 * threadIdx.x) = 0u;
  __syncthreads();
  phase_prep(p);
  phase_norm(p, 0);
  grid.sync();
  if (threadIdx.x == 0) (void)xb_add(&p.bar[XB_XCNT(xb_xcc_id())], 1u);
#pragma unroll 1
  for (int l = 0; l < 2; ++l) {
    gemm_run(p, l, 1, -1);
    grid_bar(p.bar);
    phase_p2(p, l);
    grid_bar(p.bar);
    gemm_run(p, l, 3, -1);
    grid_bar(p.bar);
    gemm_run(p, l, 4, -1);
    if (l == 0) {
      grid_bar(p.bar);
      phase_norm(p, 1);
      grid_bar(p.bar);
    }
  }
}

extern "C" void kernel_launch(void* const* d_in, const int* in_sizes, int n_in, void* d_out,
                              int out_size, void* d_ws, size_t ws_size, hipStream_t stream) {
  static int grid_blocks = 0;
  if (!grid_blocks) {
    int dev = 0, cus = 0, per_cu = 0;
    (void)hipGetDevice(&dev);
    (void)hipDeviceGetAttribute(&cus, hipDeviceAttributeMultiprocessorCount, dev);
    (void)hipFuncSetAttribute((const void*)fwd_mega, hipFuncAttributeMaxDynamicSharedMemorySize, LDS_BYTES);
    (void)hipOccupancyMaxActiveBlocksPerMultiprocessor(&per_cu, fwd_mega, NTHR, LDS_BYTES);
    if (per_cu > 1) per_cu = 1;
    if (per_cu < 1) { fprintf(stderr, "occupancy query returned 0\n"); per_cu = 1; }
    grid_blocks = cus * per_cu;
  }
  Params p{};
  p.xp = (const float*)d_in[0]; p.xs = (const float*)d_in[1]; p.cconv = (const float*)d_in[2]; p.shg = (const float*)d_in[3];
  p.ck = (const float*)d_in[4]; p.cv = (const float*)d_in[5]; p.norm_g = (const float*)d_in[6]; p.w_in = (const float*)d_in[7];
  p.conv_w = (const float*)d_in[8]; p.lb_logits = (const float*)d_in[9]; p.hg_g = (const float*)d_in[10];
  p.q_g = (const float*)d_in[11]; p.k_g = (const float*)d_in[12]; p.w_br = (const float*)d_in[13]; p.w_out = (const float*)d_in[14];
  p.out = (float*)d_out;
  char* w = (char*)d_ws; size_t off = 0;
  auto take = [&](size_t bytes) { char* r = w + off; off += (bytes + 255) & ~(size_t)255; return r; };
  p.ctr = (int*)take(256);
  p.bar = (unsigned*)take((size_t)XCD_BAR_WORDS * 4);
  p.lbv = (float*)take(2 * 512 * 4);
  p.wt_in = (u16*)take((size_t)2 * 9216 * 1024 * 2);
  p.wt_br = (u16*)take((size_t)2 * 1024 * 1536 * 2);
  p.wt_out = (u16*)take((size_t)2 * 1024 * 1024 * 2);
  p.h = (u16*)take((size_t)NTOK * 1024 * 2);
  const size_t half = (size_t)NTOK * 512 * 2;
  p.u = (u16*)take(half); p.hv = (u16*)take(half);
  p.gbuf = take((size_t)256 * 131072); p.mbuf = take((size_t)256 * 131072);
  p.gza = (u16*)take(half); p.hq = (u16*)take(half); p.gzb = (u16*)take(half); p.sq = (u16*)take(half); p.gzc = (u16*)take(half);
  p.logf = (float*)take((size_t)NTOK * 512 * 4);
  p.m = (u16*)p.logf;
  if (off > ws_size) fprintf(stderr, "workspace too small: need %zu have %zu\n", off, ws_size);
  int lo = 0, hi = 10;
  void* args[] = {&p, &lo, &hi};
  hipError_t e = hipLaunchCooperativeKernel((void*)fwd_mega, dim3(grid_blocks), dim3(NTHR), args, LDS_BYTES, stream);
  if (e != hipSuccess) fprintf(stderr, "coop launch failed: %s (grid %d)\n", hipGetErrorString(e), grid_blocks);
}
```

```cpp
#include <hip/hip_runtime.h>
#include <hip/hip_cooperative_groups.h>
#include <cstdio>
#include <type_traits>
namespace cg = cooperative_groups;

typedef unsigned short u16;
using bf16x8 = __attribute__((ext_vector_type(8))) short;
using bf16x4 = __attribute__((ext_vector_type(4))) short;
using f32x4  = __attribute__((ext_vector_type(4))) float;

#define NTOK 65792
#define NP   65536
#define NTHR 512
#define LDS_BYTES 131328
#define EPSV 1e-6f

struct Params {
  const float* xp; const float* xs; const float* cconv; const float* shg; const float* ck; const float* cv;
  const float* norm_g; const float* w_in; const float* conv_w; const float* lb_logits; const float* hg_g;
  const float* q_g; const float* k_g; const float* w_br; const float* w_out;
  float* out;
  u16* wt_in; u16* wt_br; u16* wt_out;
  u16* h;
  u16* u; u16* hv;
  u16* gza; u16* hq; u16* gzb; u16* sq; u16* gzc;
  float* logf;
  u16* m;
  float* lbv;
  int* ctr;
  unsigned* bar;
  char* gbuf; char* mbuf;
};

extern __shared__ __attribute__((aligned(16))) char smem[];

__device__ __forceinline__ int otid() { int t = threadIdx.x; asm volatile("" : "+v"(t)); return t; }

__device__ __forceinline__ u16 f2bf(float f) {
  unsigned u = __float_as_uint(f);
  u += 0x7fffu + ((u >> 16) & 1u);
  return (u16)(u >> 16);
}
__device__ __forceinline__ float bf2f(u16 h) { return __uint_as_float(((unsigned)h) << 16); }
__device__ __forceinline__ float fexp(float x) { return __builtin_amdgcn_exp2f(x * 1.44269504f); }
__device__ __forceinline__ float flog(float x) { return __builtin_amdgcn_logf(x) * 0.69314718f; }
__device__ __forceinline__ float sigmoidf_(float x) { return __builtin_amdgcn_rcpf(1.f + fexp(-x)); }
__device__ __forceinline__ float siluf_(float x) { return x * __builtin_amdgcn_rcpf(1.f + fexp(-x)); }
__device__ __forceinline__ unsigned pack2_t(float a, float b) { unsigned r; asm volatile("s_nop 1\n\tv_cvt_pk_bf16_f32 %0, %1, %2" : "=v"(r) : "v"(a), "v"(b)); return r; }
__device__ __forceinline__ unsigned pack2(float a, float b) { unsigned r; asm volatile("v_cvt_pk_bf16_f32 %0, %1, %2" : "=v"(r) : "v"(a), "v"(b)); return r; }

#define OFF_Y      0L
#define OFF_CONVP  67371008L
#define OFF_CONVS  (OFF_CONVP + 65536L)
#define OFF_HGP    (OFF_CONVS + 32768L)
#define OFF_HGS    (OFF_HGP + 4194304L)
#define OFF_KP     (OFF_HGS + 2097152L)
#define OFF_KS     (OFF_KP + 67108864L)
#define OFF_VP     (OFF_KS + 262144L)
#define OFF_VS     (OFF_VP + 67108864L)

__device__ __forceinline__ int perm256(int v) {
  const int bj = v >> 7, wc = (v >> 5) & 3, n = (v >> 4) & 1, fq = (v >> 2) & 3, j = v & 3;
  return 128 * bj + 32 * wc + 8 * fq + 4 * n + j;
}
__device__ __forceinline__ int real_col(int V) {
  const int pn = V >> 8, v = V & 255;
  if (V >= 6144) return (V & ~255) + perm256(v);
  const int bj = v >> 7, wc = (v >> 5) & 3, n = (v >> 4) & 1, fq = (v >> 2) & 3, j = v & 3;
  if (pn < 8) {
    const int seg = (pn < 4) ? (bj ? 2 : 0) : (bj ? 3 : 1);
    return seg * 512 + (pn & 3) * 128 + 32 * wc + 8 * fq + 4 * n + j;
  }
  if (pn < 16) {
    const int seg = (pn - 8) >> 1;
    return (seg == 1) ? V : (V & ~255) + perm256(v);
  }
  const int s = (pn - 16) >> 1, head = ((pn - 16) & 1) * 4 + wc;
  const int d = (s == 0 || s == 3) ? (32 * bj + 8 * fq + 4 * n + j) : (32 * bj + 16 * n + 4 * fq + j);
  return 4096 + s * 512 + head * 64 + d;
}

#define XB_TMO      128
#define XB_XCNT(j)  (256  + 64 * (j))
#define XB_XSUB(j)  (1280 + 64 * (j))
#define XB_XGEN(j)  (2304 + 64 * (j))
#define XB_TOP      3328
#define XB_TOPGEN   3392
#define XCD_BAR_WORDS 3456
#define XB_SPIN_CAP (1u << 18)
#ifndef LAS
#define LAS __attribute__((address_space(3)))
#endif

__device__ __forceinline__ unsigned xb_ld(unsigned* p)              { return __hip_atomic_load(p, __ATOMIC_RELAXED, __HIP_MEMORY_SCOPE_AGENT); }
__device__ __forceinline__ unsigned xb_add(unsigned* p, unsigned v) { return __hip_atomic_fetch_add(p, v, __ATOMIC_RELAXED, __HIP_MEMORY_SCOPE_AGENT); }
__device__ __forceinline__ unsigned xb_xcc_id() { return (unsigned)__builtin_amdgcn_s_getreg((3 << 11) | 20) & 0xFu; }
#define XB_SPIN(cond, bar) do { unsigned _sp = 0; while (cond) { __builtin_amdgcn_s_sleep(1); \
    if ((++_sp & 255u) == 0u) { if (xb_ld(&(bar)[XB_TMO])) break; if (_sp > XB_SPIN_CAP) { atomicAdd(&(bar)[XB_TMO], 1u); break; } } } } while (0)

struct XcdBarrier {
    unsigned* bar; unsigned x;
    volatile LAS unsigned* st;
};

__device__ __forceinline__ XcdBarrier xcd_barrier_post(unsigned* bar, volatile LAS unsigned* st) {
    XcdBarrier b; b.bar = bar; b.x = xb_xcc_id(); b.st = st;
    if (threadIdx.x == 0) (void)xb_add(&bar[XB_XCNT(b.x)], 1u);
    return b;
}
__device__ __forceinline__ void xcd_barrier_complete(unsigned* bar, unsigned x, unsigned& nloc, unsigned& nx) {
    const unsigned G = gridDim.x * gridDim.y * gridDim.z;
    unsigned sum, cnt, mine, sp = 0u;
    for (;;) {
        sum = 0u; cnt = 0u; mine = 0u;
#pragma unroll
        for (unsigned j = 0; j < 16; ++j) { const unsigned c = xb_ld(&bar[XB_XCNT(j)]); sum += c; cnt += (c > 0u) ? 1u : 0u; mine = (j == x) ? c : mine; }
        if (sum == G) break;
        __builtin_amdgcn_s_sleep(1);
        if ((++sp & 255u) == 0u) { if (xb_ld(&bar[XB_TMO])) break; if (sp > XB_SPIN_CAP) { atomicAdd(&bar[XB_TMO], 1u); break; } }
    }
    nloc = mine > 0u ? mine : 1u; nx = cnt > 0u ? cnt : 1u;
}

__device__ __forceinline__ void xcd_barrier(const XcdBarrier& b) {
    asm volatile("s_waitcnt vmcnt(0)" ::: "memory");
    __syncthreads();
    if (threadIdx.x == 0) {
        unsigned* bar = b.bar;
        __builtin_amdgcn_s_waitcnt(0);
        unsigned nloc = b.st[0], nx = b.st[1];
        if (nloc == 0u) { xcd_barrier_complete(bar, b.x, nloc, nx); b.st[0] = nloc; b.st[1] = nx; }
        const unsigned old = xb_add(&bar[XB_XSUB(b.x)], 1u);
        const unsigned gen = old / nloc;
        if (old + 1u == (gen + 1u) * nloc) {
            __builtin_amdgcn_fence(__ATOMIC_RELEASE, "agent");
            asm volatile("s_waitcnt vmcnt(0)" ::: "memory");
            const unsigned og = xb_add(&bar[XB_TOP], 1u);
            const unsigned tg = og / nx;
            if (og + 1u == (tg + 1u) * nx) xb_add(&bar[XB_TOPGEN], 1u);
            else XB_SPIN(xb_ld(&bar[XB_TOPGEN]) == tg, bar);
            __builtin_amdgcn_fence(__ATOMIC_ACQUIRE, "agent");
            xb_add(&bar[XB_XGEN(b.x)], 1u);
            asm volatile("s_waitcnt vmcnt(0)" ::: "memory");
        } else {
            XB_SPIN(xb_ld(&bar[XB_XGEN(b.x)]) == gen, bar);
            __builtin_amdgcn_fence(__ATOMIC_ACQUIRE, "agent");
            asm volatile("s_waitcnt vmcnt(0)" ::: "memory");
        }
    }
    __syncthreads();
}


__device__ __forceinline__ void grid_bar(unsigned* bar) {
  XcdBarrier b; b.bar = bar; b.x = xb_xcc_id(); b.st = (volatile LAS unsigned*)(smem + LDS_BYTES - 32);
  xcd_barrier(b);
}

struct TDesc { const float* src; u16* dst; int ld, K, k0, n0, mode; };
__device__ __forceinline__ TDesc tile_desc(const Params& p, int t) {
  TDesc d; const int l = t / 2944; int r = t % 2944;
  if (r < 2304) { const int kt = r / 144, nt = r % 144;
    d.src = p.w_in + (long)l * 1024 * 9216; d.ld = 9216; d.dst = p.wt_in + (long)l * 9216 * 1024; d.K = 1024; d.k0 = kt * 64; d.n0 = nt * 64; d.mode = 1;
  } else if (r < 2304 + 384) { r -= 2304; const int br = r >> 7, kt = (r & 127) >> 4, nt = r & 15;
    d.src = p.w_br + (long)l * 1536 * 1024 + (long)br * 512 * 1024; d.ld = 1024; d.dst = p.wt_br + (long)(l * 3 + br) * 1024 * 512; d.K = 512; d.k0 = kt * 64; d.n0 = nt * 64; d.mode = 2;
  } else { r -= 2304 + 384; const int kt = r / 16, nt = r % 16;
    d.src = p.w_out + (long)l * 1024 * 1024; d.ld = 1024; d.dst = p.wt_out + (long)l * 1024 * 1024; d.K = 1024; d.k0 = kt * 64; d.n0 = nt * 64; d.mode = 0;
  }
  return d;
}
__device__ __forceinline__ void tt_load(const TDesc& d, float* t, int tid) {
#pragma unroll
  for (int i = 0; i < 2; ++i) {
    const int e = tid + i * NTHR, kk = e >> 4, q = e & 15, nv = d.n0 + 4 * q;
    const int col = (d.mode == 1) ? real_col(nv) : (d.mode == 2) ? (nv & ~255) + perm256(nv & 255) : nv;
    const float4 v = *reinterpret_cast<const float4*>(d.src + (long)(d.k0 + kk) * d.ld + col);
    float* w = t + kk * 65 + 4 * q; w[0] = v.x; w[1] = v.y; w[2] = v.z; w[3] = v.w;
  }
}
__device__ __forceinline__ void tt_store(const TDesc& d, const float* t, int tid) {
  const int nn = tid >> 3, c8 = tid & 7;
  float f[8];
#pragma unroll
  for (int i = 0; i < 8; ++i) f[i] = t[(8 * c8 + i) * 65 + nn];
  uint4 o; o.x = pack2(f[0], f[1]); o.y = pack2(f[2], f[3]); o.z = pack2(f[4], f[5]); o.w = pack2(f[6], f[7]);
  *reinterpret_cast<uint4*>(d.dst + (long)(d.n0 + nn) * d.K + d.k0 + 8 * c8) = o;
}

__device__ __forceinline__ void phase_prep(const Params& p) {
  if (blockIdx.x == 0) {
    for (int i = threadIdx.x; i < 512; i += NTHR) {
      float l0 = p.lb_logits[i], l1 = p.lb_logits[512 + i];
      p.lbv[i] = 0.f;
      p.lbv[512 + i] = 1.f / (1.f + expf(l0 - l1));
    }
    if (threadIdx.x < 16) p.ctr[threadIdx.x] = 0;
    for (int i = threadIdx.x; i < XCD_BAR_WORDS; i += NTHR) p.bar[i] = 0u;
  }
  const int tid = otid();
  float* t0 = reinterpret_cast<float*>(smem); float* t1 = t0 + 64 * 65;
  for (int t = blockIdx.x; t < 2 * 2944; t += 2 * gridDim.x) {
    const int tb = t + gridDim.x; const bool two = tb < 2 * 2944;
    const TDesc d0 = tile_desc(p, t), d1 = tile_desc(p, two ? tb : t);
    tt_load(d0, t0, tid);
    if (two) tt_load(d1, t1, tid);
    __syncthreads();
    tt_store(d0, t0, tid);
    if (two) tt_store(d1, t1, tid);
    __syncthreads();
  }
}

__device__ __forceinline__ void phase_norm(const Params& p, int l) {
  const int tid = otid(), wid = tid >> 6, lane = tid & 63;
  const float* g = p.norm_g + l * 1024;
  float4 gg[4];
#pragma unroll
  for (int i = 0; i < 4; ++i) gg[i] = *reinterpret_cast<const float4*>(g + (i * 64 + lane) * 4);
  for (int row = (blockIdx.x * 8 + wid) * 2; row < NTOK; row += gridDim.x * 16) {
    float4 v[2][4]; float ss[2] = {0.f, 0.f};
#pragma unroll
    for (int r = 0; r < 2; ++r) {
      const int rr = row + r;
      const float* x = (l == 0) ? (rr < NP ? p.xp + (long)rr * 1024 : p.xs + (long)(rr - NP) * 1024) : p.out + (long)rr * 1024;
#pragma unroll
      for (int i = 0; i < 4; ++i) v[r][i] = *reinterpret_cast<const float4*>(x + (i * 64 + lane) * 4);
    }
#pragma unroll
    for (int r = 0; r < 2; ++r) {
#pragma unroll
      for (int i = 0; i < 4; ++i) ss[r] += v[r][i].x * v[r][i].x + v[r][i].y * v[r][i].y + v[r][i].z * v[r][i].z + v[r][i].w * v[r][i].w;
    }
#pragma unroll
    for (int o = 32; o >= 1; o >>= 1) { ss[0] += __shfl_xor(ss[0], o); ss[1] += __shfl_xor(ss[1], o); }
#pragma unroll
    for (int r = 0; r < 2; ++r) {
      const float rstd = rsqrtf(ss[r] * (1.f / 1024.f) + EPSV);
#pragma unroll
      for (int i = 0; i < 4; ++i) {
        const int c = (i * 64 + lane) * 4;
        uint2 o2;
        o2.x = pack2(v[r][i].x * rstd * gg[i].x, v[r][i].y * rstd * gg[i].y);
        o2.y = pack2(v[r][i].z * rstd * gg[i].z, v[r][i].w * rstd * gg[i].w);
        *reinterpret_cast<uint2*>(p.h + (long)(row + r) * 1024 + c) = o2;
      }
    }
  }
}

__device__ __forceinline__ void item_conv(const Params& p, int l, int item) {
  const float* cw = p.conv_w + l * 3 * 512;
  for (int e = threadIdx.x; e < 128 * 64; e += NTHR) {
    int tok = item * 128 + (e >> 6), c = (e & 63) * 8;
    int t, b; bool samp = tok >= NP;
    if (!samp) { t = tok & 2047; b = tok >> 11; } else { int ts = tok - NP; t = ts & 15; b = ts >> 4; }
    float y[8];
#pragma unroll
    for (int i = 0; i < 8; ++i) y[i] = 0.f;
#pragma unroll
    for (int j = 0; j < 3; ++j) {
      int pi = t + j;
      float f[8];
      if (pi >= 2) {
        uint4 raw = *reinterpret_cast<const uint4*>(p.u + (long)(tok - 2 + j) * 512 + c);
        unsigned w[4] = {raw.x, raw.y, raw.z, raw.w};
#pragma unroll
        for (int i = 0; i < 4; ++i) { f[2 * i] = __uint_as_float(w[i] << 16); f[2 * i + 1] = __uint_as_float(w[i] & 0xffff0000u); }
      } else if (samp) {
        const float* ps = p.cconv + ((long)(l * 16 + b) * 2 + pi) * 512 + c;
#pragma unroll
        for (int i = 0; i < 8; ++i) f[i] = ps[i];
      } else {
#pragma unroll
        for (int i = 0; i < 8; ++i) f[i] = 0.f;
      }
#pragma unroll
      for (int i = 0; i < 8; ++i) y[i] += f[i] * cw[j * 512 + c + i];
    }
    uint4 graw = *reinterpret_cast<const uint4*>(p.gza + (long)tok * 512 + c);
    unsigned gw[4] = {graw.x, graw.y, graw.z, graw.w};
    uint4 o;
    unsigned ow[4];
#pragma unroll
    for (int i = 0; i < 4; ++i) {
      float g0 = __uint_as_float(gw[i] << 16), g1 = __uint_as_float(gw[i] & 0xffff0000u);
      ow[i] = pack2(g0 * y[2 * i], g1 * y[2 * i + 1]);
    }
    o.x = ow[0]; o.y = ow[1]; o.z = ow[2]; o.w = ow[3];
    *reinterpret_cast<uint4*>(p.gza + (long)tok * 512 + c) = o;
  }
}

#define HQS 0
#define HKS 17408
#define HKT 34816
#define HVT 53248
#define HPS 71680
#define HSP 80896
#define HTOT 115712
#define HER 117760
#define HEL 118272
#define HSSQ 118784
__device__ __forceinline__ void item_hgrn(const Params& p, int l, int sidx) {
  const int tid = otid(), wid = __builtin_amdgcn_readfirstlane(tid >> 6), lane = tid & 63, fr = lane & 15, fq = lane >> 4;
  const bool samp = sidx >= 128;
  int b, hh, T, tok0, nchunks;
  if (!samp) { b = sidx >> 2; hh = sidx & 3; T = 2048; tok0 = b * 2048; nchunks = 32; }
  else { int s = sidx - 128; b = s >> 2; hh = s & 3; T = 16; tok0 = NP + b * 16; nchunks = 1; }
  u16* Qs = reinterpret_cast<u16*>(smem + HQS);
  u16* Ks = reinterpret_cast<u16*>(smem + HKS);
  u16* KTs = reinterpret_cast<u16*>(smem + HKT);
  u16* VTs = reinterpret_cast<u16*>(smem + HVT);
  u16* Ps = reinterpret_cast<u16*>(smem + HPS);
  u16* SpT = reinterpret_cast<u16*>(smem + HSP);
  float* tot = reinterpret_cast<float*>(smem + HTOT);
  float* er = reinterpret_cast<float*>(smem + HER);
  float* el = reinterpret_cast<float*>(smem + HEL);
  float* ssq = reinterpret_cast<float*>(smem + HSSQ);

  f32x4 S[8];
  float* Sout = p.out + (samp ? OFF_HGS + ((long)(l * 16 + b) * 4 + hh) * 16384 : OFF_HGP + ((long)(l * 32 + b) * 4 + hh) * 16384);
  if (samp) {
    const float* S0 = p.shg + ((long)(l * 16 + b) * 4 + hh) * 16384;
#pragma unroll
    for (int n = 0; n < 8; ++n)
#pragma unroll
      for (int j = 0; j < 4; ++j) S[n][j] = S0[(16 * wid + fq * 4 + j) * 128 + n * 16 + fr];
  } else {
#pragma unroll
    for (int n = 0; n < 8; ++n) S[n] = f32x4{0.f, 0.f, 0.f, 0.f};
  }
  const float* hg = p.hg_g + l * 128;
  const int c = tid & 127, qd = wid >> 1;
  float hgv[4];
#pragma unroll
  for (int n = 0; n < 4; ++n) hgv[n] = hg[(wid >> 2) * 64 + n * 16 + fr];

  float lf[16]; unsigned qraw[16]; uint4 vraw[2];
#define HG_LOAD_CHUNK(CH) do { \
    const int t0_ = (CH) * 64; \
    _Pragma("unroll") for (int i = 0; i < 16; ++i) { \
      const int t_ = t0_ + qd * 16 + i; \
      const long rb_ = (long)(tok0 + (t_ < T ? t_ : T - 1)) * 512 + hh * 128 + c; \
      lf[i] = p.logf[rb_]; qraw[i] = p.hq[rb_]; } \
    _Pragma("unroll") for (int i = 0; i < 2; ++i) { \
      const int e = tid + i * NTHR, s = e >> 4, dv0 = (e & 15) * 8; \
      vraw[i] = *reinterpret_cast<const uint4*>(p.hv + (long)(tok0 + (t0_ + s < T ? t0_ + s : T - 1)) * 512 + hh * 128 + dv0); } } while (0)
  HG_LOAD_CHUNK(0);

  for (int ch = 0; ch < nchunks; ++ch) {
    const int t0 = ch * 64;
    {
      float run = 0.f;
#pragma unroll
      for (int i = 0; i < 16; ++i) { if (t0 + qd * 16 + i >= T) { lf[i] = 0.f; qraw[i] = 0u; } run += lf[i]; }
      tot[qd * 128 + c] = run;
    }
#pragma unroll
    for (int i = 0; i < 2; ++i) {
      int e = tid + i * NTHR, s = e >> 4, dv0 = (e & 15) * 8;
      unsigned w[4] = {vraw[i].x, vraw[i].y, vraw[i].z, vraw[i].w};
      if (t0 + s >= T) { w[0] = 0u; w[1] = 0u; w[2] = 0u; w[3] = 0u; }
#pragma unroll
      for (int k = 0; k < 4; ++k) {
        VTs[(dv0 + 2 * k) * 72 + s] = (u16)(w[k] & 0xffffu);
        VTs[(dv0 + 2 * k + 1) * 72 + s] = (u16)(w[k] >> 16);
      }
    }
    __syncthreads();
    {
      float t0v = tot[c], t1v = tot[128 + c], t2v = tot[256 + c], t3v = tot[384 + c];
      float r = t0v + t1v;
      float e = (qd == 0 ? 0.f : qd == 1 ? t0v : qd == 2 ? r : r + t2v) - r;
      if (qd == 0) er[c] = fexp(fmaxf(r, -80.f));
      if (qd == 1) el[c] = fexp(fmaxf(t2v + t3v, -80.f));
      unsigned kpk[8];
#pragma unroll
      for (int i = 0; i < 16; ++i) {
        int tl = qd * 16 + i;
        float lfv = lf[i], qv = __uint_as_float(qraw[i] << 16);
        float kin = (t0 + tl < T) ? (1.f - fexp(lfv)) : 0.f;
        e += lfv;
        float eq = fexp(fminf(fmaxf(e, -80.f), 80.f));
        float ek = fexp(fminf(fmaxf(-e, -80.f), 80.f));
        u16 qb = f2bf(qv * eq), kb = f2bf(kin * ek);
        Qs[tl * 136 + c] = qb; Ks[tl * 136 + c] = kb;
        if (i & 1) kpk[i >> 1] |= ((unsigned)kb) << 16; else kpk[i >> 1] = kb;
      }
      *reinterpret_cast<uint4*>(KTs + c * 72 + qd * 16) = make_uint4(kpk[0], kpk[1], kpk[2], kpk[3]);
      *reinterpret_cast<uint4*>(KTs + c * 72 + qd * 16 + 8) = make_uint4(kpk[4], kpk[5], kpk[6], kpk[7]);
    }
    __syncthreads();
    if (ch + 1 < nchunks) HG_LOAD_CHUNK(ch + 1);
    unsigned gzr[4][4];
    {
      const int tt_ = wid & 3, dvh_ = wid >> 2;
#pragma unroll
      for (int j = 0; j < 4; ++j)
#pragma unroll
        for (int n = 0; n < 4; ++n) {
          int tl = tt_ * 16 + fq * 4 + j;
          int tr = t0 + tl < T ? t0 + tl : T - 1;
          gzr[j][n] = p.gzb[(long)(tok0 + tr) * 512 + hh * 128 + dvh_ * 64 + n * 16 + fr];
        }
    }
    {
      float e4[4];
#pragma unroll
      for (int j = 0; j < 4; ++j) e4[j] = er[16 * wid + fq * 4 + j];
#pragma unroll
      for (int n = 0; n < 8; ++n) {
#pragma unroll
        for (int j = 0; j < 4; ++j) S[n][j] *= e4[j];
        uint2 o2; o2.x = pack2(S[n][0], S[n][1]); o2.y = pack2(S[n][2], S[n][3]);
        *reinterpret_cast<uint2*>(SpT + (n * 16 + fr) * 136 + 16 * wid + fq * 4) = o2;
      }
    }
    {
      const int tt = wid >> 1;
#pragma unroll
      for (int q2 = 0; q2 < 2; ++q2) {
        const int st = 2 * (wid & 1) + q2;
        f32x4 pa = f32x4{0.f, 0.f, 0.f, 0.f};
        if (st <= tt) {
#pragma unroll
          for (int ks = 0; ks < 4; ++ks) {
            bf16x8 a = *reinterpret_cast<const bf16x8*>(Qs + (tt * 16 + fr) * 136 + ks * 32 + fq * 8);
            bf16x8 bb = *reinterpret_cast<const bf16x8*>(Ks + (st * 16 + fr) * 136 + ks * 32 + fq * 8);
            pa = __builtin_amdgcn_mfma_f32_16x16x32_bf16(a, bb, pa, 0, 0, 0);
          }
        }
#pragma unroll
        for (int j = 0; j < 4; ++j) {
          int trow = tt * 16 + fq * 4 + j, scol = st * 16 + fr;
          float v = (scol <= trow) ? pa[j] : 0.f;
          Ps[trow * 72 + scol] = f2bf(v);
        }
      }
    }
    __syncthreads();
    f32x4 oacc[4];
    const int tt = wid & 3, dvh = wid >> 2;
    {
#pragma unroll
      for (int n = 0; n < 4; ++n) oacc[n] = f32x4{0.f, 0.f, 0.f, 0.f};
#pragma unroll
      for (int ks = 0; ks < 2; ++ks) {
        bf16x8 a = *reinterpret_cast<const bf16x8*>(Ps + (tt * 16 + fr) * 72 + ks * 32 + fq * 8);
#pragma unroll
        for (int n = 0; n < 4; ++n) {
          bf16x8 bb = *reinterpret_cast<const bf16x8*>(VTs + (dvh * 64 + n * 16 + fr) * 72 + ks * 32 + fq * 8);
          oacc[n] = __builtin_amdgcn_mfma_f32_16x16x32_bf16(a, bb, oacc[n], 0, 0, 0);
        }
      }
#pragma unroll
      for (int ks = 0; ks < 4; ++ks) {
        bf16x8 a = *reinterpret_cast<const bf16x8*>(Qs + (tt * 16 + fr) * 136 + ks * 32 + fq * 8);
#pragma unroll
        for (int n = 0; n < 4; ++n) {
          bf16x8 bb = *reinterpret_cast<const bf16x8*>(SpT + (dvh * 64 + n * 16 + fr) * 136 + ks * 32 + fq * 8);
          oacc[n] = __builtin_amdgcn_mfma_f32_16x16x32_bf16(a, bb, oacc[n], 0, 0, 0);
        }
      }
#pragma unroll
      for (int j = 0; j < 4; ++j) {
        float ss = 0.f;
#pragma unroll
        for (int n = 0; n < 4; ++n) ss += oacc[n][j] * oacc[n][j];
        ss += __shfl_xor(ss, 1); ss += __shfl_xor(ss, 2); ss += __shfl_xor(ss, 4); ss += __shfl_xor(ss, 8);
        if (fr == 0) ssq[dvh * 64 + tt * 16 + fq * 4 + j] = ss;
      }
    }
    {
#pragma unroll
      for (int ks = 0; ks < 2; ++ks) {
        bf16x8 a = *reinterpret_cast<const bf16x8*>(KTs + (16 * wid + fr) * 72 + ks * 32 + fq * 8);
#pragma unroll
        for (int n = 0; n < 8; ++n) {
          bf16x8 bb = *reinterpret_cast<const bf16x8*>(VTs + (n * 16 + fr) * 72 + ks * 32 + fq * 8);
          S[n] = __builtin_amdgcn_mfma_f32_16x16x32_bf16(a, bb, S[n], 0, 0, 0);
        }
      }
      float e4[4];
#pragma unroll
      for (int j = 0; j < 4; ++j) e4[j] = el[16 * wid + fq * 4 + j];
#pragma unroll
      for (int n = 0; n < 8; ++n)
#pragma unroll
        for (int j = 0; j < 4; ++j) S[n][j] *= e4[j];
    }
    __syncthreads();
#pragma unroll
    for (int j = 0; j < 4; ++j) {
      int tl = tt * 16 + fq * 4 + j;
      if (t0 + tl < T) {
        float ss = ssq[tl] + ssq[64 + tl];
        float rstd = rsqrtf(ss * (1.f / 128.f) + EPSV);
#pragma unroll
        for (int n = 0; n < 4; ++n) {
          int dv = dvh * 64 + n * 16 + fr;
          long idx = (long)(tok0 + t0 + tl) * 512 + hh * 128 + dv;
          float g = __uint_as_float(gzr[j][n] << 16);
          p.gzb[idx] = f2bf(oacc[n][j] * rstd * hgv[n] * g);
        }
      }
    }
  }
#pragma unroll
  for (int n = 0; n < 8; ++n)
#pragma unroll
    for (int j = 0; j < 4; ++j) Sout[(16 * wid + fq * 4 + j) * 128 + n * 16 + fr] = S[n][j];
  __syncthreads();
#undef HG_LOAD_CHUNK
}

#define AKS 0
#define AVT 9216
__device__ __forceinline__ void item_attn(const Params& p, int l, int aidx) {
  const int tid = otid(), wid = __builtin_amdgcn_readfirstlane(tid >> 6), lane = tid & 63, fr = lane & 15, fq = lane >> 4;
  const bool samp = aidx >= 2048;
  int b, hd, nq, qpos0, ntiles; long tokq0;
  const float *kbase, *vbase, *kcache = nullptr, *vcache = nullptr;
  if (!samp) {
    int qb = 7 - (aidx >> 8); int r = aidx & 255; b = r >> 3; hd = r & 7;
    nq = 256; qpos0 = qb * 256; tokq0 = (long)b * 2048 + qpos0; ntiles = qb * 4 + 4;
    kbase = p.out + OFF_KP + ((long)l * 65536 + (long)b * 2048) * 512 + hd * 64;
    vbase = p.out + OFF_VP + ((long)l * 65536 + (long)b * 2048) * 512 + hd * 64;
  } else {
    int r = aidx - 2048; b = r >> 3; hd = r & 7;
    nq = 16; qpos0 = 1024; tokq0 = NP + (long)b * 16; ntiles = 17;
    kbase = p.out + OFF_KS + ((long)l * 256 + (long)b * 16) * 512 + hd * 64;
    vbase = p.out + OFF_VS + ((long)l * 256 + (long)b * 16) * 512 + hd * 64;
    kcache = p.ck + ((long)(l * 16 + b) * 1024) * 512 + hd * 64;
    vcache = p.cv + ((long)(l * 16 + b) * 1024) * 512 + hd * 64;
  }
  u16* Ks = reinterpret_cast<u16*>(smem + AKS);
  u16* VT = reinterpret_cast<u16*>(smem + AVT);

  bf16x8 qf[2][2];
  bool rowv[2];
#pragma unroll
  for (int n = 0; n < 2; ++n) {
    int row = 32 * wid + 16 * n + fr;
    rowv[n] = row < nq;
#pragma unroll
    for (int ks = 0; ks < 2; ++ks) {
      bf16x8 z = {0, 0, 0, 0, 0, 0, 0, 0};
      if (rowv[n]) z = *reinterpret_cast<const bf16x8*>(p.sq + (tokq0 + row) * 512 + hd * 64 + ks * 32 + fq * 8);
      qf[n][ks] = z;
    }
  }
  const bool wave_has_rows = (32 * wid) < nq;
  f32x4 oacc[4][2];
#pragma unroll
  for (int md = 0; md < 4; ++md)
#pragma unroll
    for (int n = 0; n < 2; ++n) oacc[md][n] = f32x4{0.f, 0.f, 0.f, 0.f};
  float carry[2] = {1.f, 1.f};
  const int wave_qmax = qpos0 + 32 * wid + 31;

  float4 kreg[2][2]; float vreg[2][8];
#define ATT_LOAD_TILE(KT, S) do { \
    _Pragma("unroll") for (int i = 0; i < 2; ++i) { \
      const int e = tid + i * NTHR, key = e >> 4, d0 = (e & 15) * 4, pos = (KT) * 64 + key; \
      const float* kp_ = kbase + (long)pos * 512; \
      if (samp) { const int pc_ = pos < 1039 ? pos : 1039; \
        kp_ = (pos < 1024) ? kcache + (long)pc_ * 512 : kbase + (long)(pc_ - 1024) * 512; } \
      kreg[S][i] = *reinterpret_cast<const float4*>(kp_ + d0); } \
    _Pragma("unroll") for (int i = 0; i < 8; ++i) { \
      const int pos = (KT) * 64 + 8 * wid + i; \
      const float* vp_ = vbase + (long)pos * 512; \
      if (samp) { const int pc_ = pos < 1039 ? pos : 1039; \
        vp_ = (pos < 1024) ? vcache + (long)pc_ * 512 : vbase + (long)(pc_ - 1024) * 512; } \
      vreg[S][i] = vp_[lane]; } } while (0)
  ATT_LOAD_TILE(ntiles - 1, 0);
  if (ntiles > 1) ATT_LOAD_TILE(ntiles - 2, 1);
  bool wave_done = !wave_has_rows;

  bool all_done = false;
  for (int kt0 = ntiles - 1; kt0 >= 0 && !all_done; kt0 -= 2) {
#pragma unroll
  for (int hs = 0; hs < 2; ++hs) {
    const int kt = kt0 - hs;
    if (kt < 0 || all_done) break;
#pragma unroll
    for (int i = 0; i < 2; ++i) {
      const int e = tid + i * NTHR, key = e >> 4, d0 = (e & 15) * 4;
      if (samp && kt * 64 + key >= 1040) kreg[hs][i] = make_float4(0.f, 0.f, 0.f, 0.f);
      uint2 k2; k2.x = pack2(kreg[hs][i].x, kreg[hs][i].y); k2.y = pack2(kreg[hs][i].z, kreg[hs][i].w);
      *reinterpret_cast<uint2*>(Ks + key * 72 + d0) = k2;
    }
    {
      if (samp) {
#pragma unroll
        for (int i = 0; i < 8; ++i) if (kt * 64 + 8 * wid + i >= 1040) vreg[hs][i] = 0.f;
      }
      uint4 v4; v4.x = pack2(vreg[hs][0], vreg[hs][1]); v4.y = pack2(vreg[hs][2], vreg[hs][3]); v4.z = pack2(vreg[hs][4], vreg[hs][5]); v4.w = pack2(vreg[hs][6], vreg[hs][7]);
      *reinterpret_cast<uint4*>(VT + lane * 72 + 8 * wid) = v4;
    }
    __syncthreads();
    if (kt > 1) ATT_LOAD_TILE(kt - 2, hs);
    if (!wave_done && kt * 64 < wave_qmax) {
      f32x4 z[4][2];
#pragma unroll
      for (int m = 0; m < 4; ++m) {
        bf16x8 a0 = *reinterpret_cast<const bf16x8*>(Ks + (m * 16 + fr) * 72 + fq * 8);
        bf16x8 a1 = *reinterpret_cast<const bf16x8*>(Ks + (m * 16 + fr) * 72 + 32 + fq * 8);
#pragma unroll
        for (int n = 0; n < 2; ++n) {
          f32x4 zz = f32x4{0.f, 0.f, 0.f, 0.f};
          zz = __builtin_amdgcn_mfma_f32_16x16x32_bf16(a0, qf[n][0], zz, 0, 0, 0);
          zz = __builtin_amdgcn_mfma_f32_16x16x32_bf16(a1, qf[n][1], zz, 0, 0, 0);
          z[m][n] = zz;
        }
      }
      unsigned pk[4][2][2];
      auto sb_weights = [&](auto MASKED) {
#pragma unroll
        for (int n = 0; n < 2; ++n) {
          const int qpos = qpos0 + 32 * wid + 16 * n + fr;
          float wgt[4][4], excl[4][4], later[4], TT[4];
#pragma unroll
          for (int m = 0; m < 4; ++m) {
            float f[4];
#pragma unroll
            for (int j = 0; j < 4; ++j) {
              const float e = fexp(fminf(-z[m][n][j], 80.f));
              const float sg = __builtin_amdgcn_rcpf(1.f + e);
              if (decltype(MASKED)::value) {
                const bool ok = (kt * 64 + m * 16 + fq * 4 + j) < qpos;
                wgt[m][j] = ok ? sg : 0.f;
                f[j] = ok ? e * sg : 1.f;
              } else { wgt[m][j] = sg; f[j] = e * sg; }
            }
            excl[m][3] = 1.f; excl[m][2] = f[3]; excl[m][1] = f[3] * f[2]; excl[m][0] = excl[m][1] * f[1];
            const float G = excl[m][0] * f[0];
            const float g1 = __shfl_xor(G, 16), g2 = __shfl_xor(G, 32), g3 = __shfl_xor(G, 48);
            later[m] = ((fq ^ 1) > fq ? g1 : 1.f) * ((fq ^ 2) > fq ? g2 : 1.f) * ((fq ^ 3) > fq ? g3 : 1.f);
            TT[m] = (G * g1) * (g2 * g3);
          }
          float lm[4]; lm[3] = carry[n]; lm[2] = lm[3] * TT[3]; lm[1] = lm[2] * TT[2]; lm[0] = lm[1] * TT[1];
#pragma unroll
          for (int m = 0; m < 4; ++m) {
            const float base = later[m] * lm[m];
            float pv[4];
#pragma unroll
            for (int j = 0; j < 4; ++j) pv[j] = wgt[m][j] * excl[m][j] * base;
            pk[m][n][0] = pack2(pv[0], pv[1]); pk[m][n][1] = pack2(pv[2], pv[3]);
          }
          carry[n] = lm[0] * TT[0];
        }
      };
      if (kt * 64 + 63 < qpos0 + 32 * wid) sb_weights(std::false_type{}); else sb_weights(std::true_type{});
#pragma unroll
      for (int kk = 0; kk < 2; ++kk) {
        bf16x8 pb[2];
#pragma unroll
        for (int n = 0; n < 2; ++n) {
          union { unsigned u[4]; bf16x8 v; } cv;
          cv.u[0] = pk[2 * kk][n][0]; cv.u[1] = pk[2 * kk][n][1]; cv.u[2] = pk[2 * kk + 1][n][0]; cv.u[3] = pk[2 * kk + 1][n][1];
          pb[n] = cv.v;
        }
#pragma unroll
        for (int md = 0; md < 4; ++md) {
          union { uint2 h[2]; bf16x8 v; } av;
          av.h[0] = *reinterpret_cast<const uint2*>(VT + (md * 16 + fr) * 72 + kk * 32 + fq * 4);
          av.h[1] = *reinterpret_cast<const uint2*>(VT + (md * 16 + fr) * 72 + kk * 32 + 16 + fq * 4);
#pragma unroll
          for (int n = 0; n < 2; ++n) oacc[md][n] = __builtin_amdgcn_mfma_f32_16x16x32_bf16(av.v, pb[n], oacc[md][n], 0, 0, 0);
        }
      }
      wave_done = __all(((carry[0] < 1e-36f) || !rowv[0]) && ((carry[1] < 1e-36f) || !rowv[1]));
    }
    if (__syncthreads_and(wave_done ? 1 : 0)) all_done = true;
  }
  }
#undef ATT_LOAD_TILE
  {
    uint2 gz[2][4];
#pragma unroll
    for (int n = 0; n < 2; ++n) {
      int row = 32 * wid + 16 * n + fr; if (row >= nq) row = nq - 1;
#pragma unroll
      for (int md = 0; md < 4; ++md) gz[n][md] = *reinterpret_cast<const uint2*>(p.gzc + (tokq0 + row) * 512 + hd * 64 + md * 16 + fq * 4);
    }
#pragma unroll
    for (int n = 0; n < 2; ++n) {
      const int row = 32 * wid + 16 * n + fr;
#pragma unroll
      for (int md = 0; md < 4; ++md) {
        const uint2 g2 = gz[n][md];
        float g0 = __uint_as_float(g2.x << 16), g1 = __uint_as_float(g2.x & 0xffff0000u);
        float g2f = __uint_as_float(g2.y << 16), g3 = __uint_as_float(g2.y & 0xffff0000u);
        uint2 o2; o2.x = pack2(oacc[md][n][0] * g0, oacc[md][n][1] * g1); o2.y = pack2(oacc[md][n][2] * g2f, oacc[md][n][3] * g3);
        if (row < nq) *reinterpret_cast<uint2*>(p.sq + (tokq0 + row) * 512 + hd * 64 + md * 16 + fq * 4) = o2;
      }
    }
  }
}

#ifndef LAS
#define LAS __attribute__((address_space(3)))
#endif
__device__ __forceinline__ int lds_byte(int r, int c) { const int st = (r >> 4) * 2 + (c >> 5), rr = r & 15, cc = c & 31, ob = rr * 64 + cc * 2; return st * 1024 + (ob ^ (((ob >> 9) & 1) << 5)); }
__device__ __forceinline__ void stage_rc(int b, int& R, int& C) { const int st = b / 1024, sb = b % 1024, swz = sb ^ (((sb >> 9) & 1) << 5); R = (st >> 1) * 16 + swz / 64; C = (st & 1) * 32 + (swz % 64) / 2; }

struct GUnit { const char* A; const char* B; int ld; int nt; int pm, pn, sub; };

__device__ __forceinline__ bool gemm_unit(const Params& p, int l, int kind, int single, int i, GUnit& u) {
  const int nN = (kind == 1) ? 24 : 4, nM = (kind == 1) ? 257 : 256, nwg = nM * nN, nsub = (kind == 3) ? 6 : 1;
  const int G = gridDim.x, c = blockIdx.x;
  const int ti = i / nsub; u.sub = i - ti * nsub;
  const long L = (single >= 0) ? (ti == 0 ? 0 : nwg) : (long)ti * G + c; if (L >= nwg) return false;
  int wgid = (int)L; { const int q = nwg / 8, r = nwg % 8, xcd = wgid % 8, off = wgid / 8; wgid = (xcd < r ? xcd * (q + 1) : r * (q + 1) + (xcd - r) * q) + off; }
  const int nig = 8 * nN, gid = wgid / nig, fm = gid * 8, gsz = (nM - fm) < 8 ? (nM - fm) : 8;
  u.pm = fm + ((wgid % nig) % gsz); u.pn = (wgid % nig) / gsz;
  if (single >= 0) { u.pm = 256; u.pn = single; }
  const u16* Win = p.wt_in + (long)l * 9216 * 1024;
  if (kind == 1) { u.A = (const char*)(p.h + (long)u.pm * 256 * 1024); u.B = (const char*)(Win + (long)u.pn * 256 * 1024); u.ld = 1024; }
  else if (kind == 4) { u.A = (const char*)(p.m + (long)u.pm * 256 * 1024); u.B = (const char*)(p.wt_out + (long)l * 1024 * 1024 + (long)u.pn * 256 * 1024); u.ld = 1024; }
  else {
    const int br = u.sub >> 1;
    if (u.sub & 1) { u.A = (const char*)(p.h + (long)u.pm * 256 * 1024); u.B = (const char*)(Win + (long)(6144 + br * 1024 + u.pn * 256) * 1024); u.ld = 1024; }
    else {
      const u16* O = (br == 0 ? p.gza : br == 1 ? p.gzb : p.sq);
      u.A = (const char*)(O + (long)u.pm * 256 * 512); u.B = (const char*)(p.wt_br + (long)(l * 3 + br) * 1024 * 512 + (long)u.pn * 256 * 512); u.ld = 512;
    }
  }
  u.nt = u.ld >> 6;
  return true;
}

__device__ __forceinline__ void gemm_epi(const Params& p, int l, int kind, const GUnit& u, f32x4 (&acc)[2][2][4][2]) {
  const int tid = otid(), wid = __builtin_amdgcn_readfirstlane(tid >> 6), lane = tid & 63, wr = wid >> 2, wc = wid & 3, fr = lane & 15, fq = lane >> 4;
  int row0 = u.pm * 256 + wr * 64 + fr;
  asm volatile("" : "+v"(row0));
  if (kind == 4) {
    const int col0 = u.pn * 256 + wc * 32 + 4 * fq;
    const float* xbase = (l == 0) ? (u.pm < 256 ? p.xp : p.xs - (long)NP * 1024) : p.out;
#pragma unroll
    for (int ai = 0; ai < 2; ++ai) {
      f32x4 xv[4][2][2];
#pragma unroll
      for (int m = 0; m < 4; ++m) {
        const float* xr = xbase + (long)(row0 + ai * 128 + m * 16) * 1024 + col0;
#pragma unroll
        for (int bj = 0; bj < 2; ++bj)
#pragma unroll
          for (int n = 0; n < 2; ++n) xv[m][bj][n] = *reinterpret_cast<const f32x4*>(xr + bj * 128 + n * 16);
      }
#pragma unroll
      for (int m = 0; m < 4; ++m) {
        float* yr = p.out + (long)(row0 + ai * 128 + m * 16) * 1024 + col0;
#pragma unroll
        for (int bj = 0; bj < 2; ++bj)
#pragma unroll
          for (int n = 0; n < 2; ++n) *reinterpret_cast<f32x4*>(yr + bj * 128 + n * 16) = xv[m][bj][n] + acc[ai][bj][m][n];
      }
      __builtin_amdgcn_sched_barrier(0);
    }
  } else if (kind == 3) {
    char* gbu = p.gbuf + (long)blockIdx.x * 131072;
    char* mbu = p.mbuf + (long)blockIdx.x * 131072;
    unsigned lo16 = (unsigned)tid * 16u;
    asm volatile("" : "+v"(lo16));
    const int br = u.sub >> 1;
    if (!(u.sub & 1)) {
#pragma unroll
      for (int ai = 0; ai < 2; ++ai)
#pragma unroll
        for (int bj = 0; bj < 2; ++bj)
#pragma unroll
          for (int m = 0; m < 4; ++m) {
            const int q = (ai * 2 + bj) * 4 + m;
            const f32x4 a0 = acc[ai][bj][m][0], a1 = acc[ai][bj][m][1];
            uint4 o;
            o.x = pack2(a0[0], a0[1]); o.y = pack2(a0[2], a0[3]); o.z = pack2(a1[0], a1[1]); o.w = pack2(a1[2], a1[3]);
            *reinterpret_cast<uint4*>((gbu + q * 8192) + lo16) = o;
          }
    } else {
#pragma unroll
      for (int ai = 0; ai < 2; ++ai) {
        uint4 g[2][4], mm[2][4];
#pragma unroll
        for (int bj = 0; bj < 2; ++bj)
#pragma unroll
          for (int m = 0; m < 4; ++m) {
            const int q = (ai * 2 + bj) * 4 + m;
            g[bj][m] = *reinterpret_cast<const uint4*>((gbu + q * 8192) + lo16);
            mm[bj][m] = *reinterpret_cast<const uint4*>((mbu + q * 8192) + lo16);
          }
#pragma unroll
        for (int bj = 0; bj < 2; ++bj)
#pragma unroll
          for (int m = 0; m < 4; ++m) {
            const int q = (ai * 2 + bj) * 4 + m;
            const uint4 yy = g[bj][m]; uint4 mo = mm[bj][m];
            mo.x = (br > 0) ? mo.x : 0u; mo.y = (br > 0) ? mo.y : 0u; mo.z = (br > 0) ? mo.z : 0u; mo.w = (br > 0) ? mo.w : 0u;
            f32x4 s0 = acc[ai][bj][m][0], s1 = acc[ai][bj][m][1];
#pragma unroll
            for (int j = 0; j < 4; ++j) { s0[j] = sigmoidf_(s0[j]); s1[j] = sigmoidf_(s1[j]); }
            uint4 o;
            o.x = pack2(__uint_as_float(yy.x << 16) * s0[0] + __uint_as_float(mo.x << 16), __uint_as_float(yy.x & 0xffff0000u) * s0[1] + __uint_as_float(mo.x & 0xffff0000u));
            o.y = pack2(__uint_as_float(yy.y << 16) * s0[2] + __uint_as_float(mo.y << 16), __uint_as_float(yy.y & 0xffff0000u) * s0[3] + __uint_as_float(mo.y & 0xffff0000u));
            o.z = pack2(__uint_as_float(yy.z << 16) * s1[0] + __uint_as_float(mo.z << 16), __uint_as_float(yy.z & 0xffff0000u) * s1[1] + __uint_as_float(mo.z & 0xffff0000u));
            o.w = pack2(__uint_as_float(yy.w << 16) * s1[2] + __uint_as_float(mo.w << 16), __uint_as_float(yy.w & 0xffff0000u) * s1[3] + __uint_as_float(mo.w & 0xffff0000u));
            if (br < 2) *reinterpret_cast<uint4*>((mbu + q * 8192) + lo16) = o;
            mm[bj][m] = o;
          }
        if (br == 2) {
          unsigned mo16 = (unsigned)((row0 - u.pm * 256) * 1024 + (wc * 32 + 8 * fq)) * 2u;
          asm volatile("" : "+v"(mo16));
          char* mrow = (char*)(p.m + (long)u.pm * 256 * 1024 + u.pn * 256);
#pragma unroll
          for (int bj = 0; bj < 2; ++bj)
#pragma unroll
            for (int m = 0; m < 4; ++m)
              *reinterpret_cast<uint4*>((mrow + ((ai * 128 + m * 16) * 1024 + bj * 128) * 2) + mo16) = mm[bj][m];
        }
        __builtin_amdgcn_sched_barrier(0);
      }
    }
  } else {
    const int pn = u.pn;
    if (pn < 8) {
      const int ch = (pn & 3) * 128 + wc * 32 + 8 * fq;
      if (pn < 4) {
#pragma unroll
        for (int ai = 0; ai < 2; ++ai)
#pragma unroll
          for (int m = 0; m < 4; ++m) {
            const int tok = row0 + ai * 128 + m * 16;
            const f32x4 u0 = acc[ai][1][m][0] * acc[ai][0][m][0], u1 = acc[ai][1][m][1] * acc[ai][0][m][1];
            uint4 o; o.x = pack2(u0[0], u0[1]); o.y = pack2(u0[2], u0[3]); o.z = pack2(u1[0], u1[1]); o.w = pack2(u1[2], u1[3]);
            *reinterpret_cast<uint4*>(p.u + (long)tok * 512 + ch) = o;
            if (tok < NP) {
              int tt = tok & 2047, bb = tok >> 11;
              if (tt >= 2046) { float* d = p.out + OFF_CONVP + ((long)(l * 32 + bb) * 2 + (tt - 2046)) * 512 + ch;
                *reinterpret_cast<f32x4*>(d) = u0; *reinterpret_cast<f32x4*>(d + 4) = u1; }
            } else {
              int ts = tok - NP, tt = ts & 15, bb = ts >> 4;
              if (tt >= 14) { float* d = p.out + OFF_CONVS + ((long)(l * 16 + bb) * 2 + (tt - 14)) * 512 + ch;
                *reinterpret_cast<f32x4*>(d) = u0; *reinterpret_cast<f32x4*>(d + 4) = u1; }
            }
          }
      } else {
#pragma unroll
        for (int ai = 0; ai < 2; ++ai)
#pragma unroll
          for (int m = 0; m < 4; ++m) {
            const int tok = row0 + ai * 128 + m * 16;
            const f32x4 b0 = acc[ai][0][m][0], b1 = acc[ai][0][m][1], z0 = acc[ai][1][m][0], z1 = acc[ai][1][m][1];
            uint4 o;
            o.x = pack2(b0[0] * siluf_(z0[0]), b0[1] * siluf_(z0[1])); o.y = pack2(b0[2] * siluf_(z0[2]), b0[3] * siluf_(z0[3]));
            o.z = pack2(b1[0] * siluf_(z1[0]), b1[1] * siluf_(z1[1])); o.w = pack2(b1[2] * siluf_(z1[2]), b1[3] * siluf_(z1[3]));
            *reinterpret_cast<uint4*>(p.gza + (long)tok * 512 + ch) = o;
          }
      }
    } else if (pn < 16) {
      const int seg = (pn - 8) >> 1, cb = ((pn - 8) & 1) * 256 + wc * 32 + 4 * fq;
      if (seg == 1) {
        f32x4 lbv4[2][2];
#pragma unroll
        for (int bj = 0; bj < 2; ++bj)
#pragma unroll
          for (int n = 0; n < 2; ++n) lbv4[bj][n] = *reinterpret_cast<const f32x4*>(p.lbv + l * 512 + cb + bj * 128 + n * 16);
#pragma unroll
        for (int ai = 0; ai < 2; ++ai)
#pragma unroll
          for (int m = 0; m < 4; ++m) {
            float* dst = p.logf + (long)(row0 + ai * 128 + m * 16) * 512 + cb;
#pragma unroll
            for (int bj = 0; bj < 2; ++bj)
#pragma unroll
              for (int n = 0; n < 2; ++n) {
                const f32x4 v = acc[ai][bj][m][n], lb = lbv4[bj][n];
                f32x4 o;
#pragma unroll
                for (int j = 0; j < 4; ++j) o[j] = flog(lb[j] + (1.f - lb[j]) * sigmoidf_(v[j]));
                *reinterpret_cast<f32x4*>(dst + bj * 128 + n * 16) = o;
              }
          }
      } else {
        u16* dbase = (seg == 0) ? p.hq : (seg == 2) ? p.hv : p.gzb;
        const int cbp = ((pn - 8) & 1) * 256 + wc * 32 + 8 * fq;
#pragma unroll
        for (int ai = 0; ai < 2; ++ai)
#pragma unroll
          for (int m = 0; m < 4; ++m) {
            u16* dst = dbase + (long)(row0 + ai * 128 + m * 16) * 512 + cbp;
#pragma unroll
            for (int bj = 0; bj < 2; ++bj) {
              f32x4 v0 = acc[ai][bj][m][0], v1 = acc[ai][bj][m][1];
              if (seg == 3) {
#pragma unroll
                for (int j = 0; j < 4; ++j) { v0[j] = siluf_(v0[j]); v1[j] = siluf_(v1[j]); }
              }
              uint4 o; o.x = pack2(v0[0], v0[1]); o.y = pack2(v0[2], v0[3]); o.z = pack2(v1[0], v1[1]); o.w = pack2(v1[2], v1[3]);
              *reinterpret_cast<uint4*>(dst + bj * 128) = o;
            }
          }
      }
    } else {
      const int seg = (pn - 16) >> 1, head = ((pn - 16) & 1) * 4 + wc;
      const int dl = head * 64 + 4 * fq, dlp = head * 64 + 8 * fq;
      if (seg < 2) {
        const float* gp = (seg == 0) ? p.q_g + l * 64 + 8 * fq : p.k_g + l * 64 + 4 * fq;
        f32x4 g4[2][2];
#pragma unroll
        for (int bj = 0; bj < 2; ++bj)
#pragma unroll
          for (int n = 0; n < 2; ++n) g4[bj][n] = *reinterpret_cast<const f32x4*>(gp + 32 * bj + (seg == 0 ? 4 * n : 16 * n));
        float* kP = p.out + OFF_KP + (long)l * 65536 * 512;
        float* kS = p.out + OFF_KS + (long)l * 256 * 512 - (long)NP * 512;
        float* kb = (u.pm < 256) ? kP : kS;
#pragma unroll
        for (int ai = 0; ai < 2; ++ai)
#pragma unroll
          for (int m = 0; m < 4; ++m) {
            const int tok = row0 + ai * 128 + m * 16;
            float ss = 0.f;
#pragma unroll
            for (int bj = 0; bj < 2; ++bj)
#pragma unroll
              for (int n = 0; n < 2; ++n) { f32x4 v = acc[ai][bj][m][n]; ss += v[0] * v[0] + v[1] * v[1] + v[2] * v[2] + v[3] * v[3]; }
            ss += __shfl_xor(ss, 16); ss += __shfl_xor(ss, 32);
            const float rstd = rsqrtf(ss * (1.f / 64.f) + EPSV) * (seg == 0 ? 0.125f : 1.f);
#pragma unroll
            for (int bj = 0; bj < 2; ++bj) {
              const f32x4 v0 = acc[ai][bj][m][0] * rstd * g4[bj][0], v1 = acc[ai][bj][m][1] * rstd * g4[bj][1];
              if (seg == 1) {
                *reinterpret_cast<f32x4*>(kb + (long)tok * 512 + dl + 32 * bj) = v0;
                *reinterpret_cast<f32x4*>(kb + (long)tok * 512 + dl + 32 * bj + 16) = v1;
              } else {
                uint4 o; o.x = pack2(v0[0], v0[1]); o.y = pack2(v0[2], v0[3]); o.z = pack2(v1[0], v1[1]); o.w = pack2(v1[2], v1[3]);
                *reinterpret_cast<uint4*>(p.sq + (long)tok * 512 + dlp + 32 * bj) = o;
              }
            }
          }
      } else if (seg == 2) {
        float* vP = p.out + OFF_VP + (long)l * 65536 * 512;
        float* vS = p.out + OFF_VS + (long)l * 256 * 512 - (long)NP * 512;
        float* vb = (u.pm < 256) ? vP : vS;
#pragma unroll
        for (int ai = 0; ai < 2; ++ai)
#pragma unroll
          for (int m = 0; m < 4; ++m) {
            float* dst = vb + (long)(row0 + ai * 128 + m * 16) * 512 + dl;
#pragma unroll
            for (int bj = 0; bj < 2; ++bj)
#pragma unroll
              for (int n = 0; n < 2; ++n) *reinterpret_cast<f32x4*>(dst + 32 * bj + 16 * n) = acc[ai][bj][m][n];
          }
      } else {
#pragma unroll
        for (int ai = 0; ai < 2; ++ai)
#pragma unroll
          for (int m = 0; m < 4; ++m) {
            u16* dst = p.gzc + (long)(row0 + ai * 128 + m * 16) * 512 + dlp;
#pragma unroll
            for (int bj = 0; bj < 2; ++bj) {
              f32x4 v0 = acc[ai][bj][m][0], v1 = acc[ai][bj][m][1];
#pragma unroll
              for (int j = 0; j < 4; ++j) { v0[j] = siluf_(v0[j]); v1[j] = siluf_(v1[j]); }
              uint4 o; o.x = pack2(v0[0], v0[1]); o.y = pack2(v0[2], v0[3]); o.z = pack2(v1[0], v1[1]); o.w = pack2(v1[2], v1[3]);
              *reinterpret_cast<uint4*>(dst + 32 * bj) = o;
            }
          }
      }
    }
  }
}

__device__ __forceinline__ void gemm_run(const Params& p, int l, int kind, int single) {
  LAS unsigned char* lds = (LAS unsigned char*)smem;
  const int tid = otid(), wid = __builtin_amdgcn_readfirstlane(tid >> 6), lane = tid & 63, wr = wid >> 2, wc = wid & 3, fr = lane & 15, fq = lane >> 4;
  constexpr int HTB = 128 * 64 * 2;
  int sR[2], sC[2];
#pragma unroll
  for (int i = 0; i < 2; ++i) stage_rc(tid * 16 + i * 8192, sR[i], sC[i]);
  const size_t kstep = 128;
  const unsigned ldsw = (unsigned)wid * 1024u;
  const int aoff = lds_byte(wr * 64 + fr, fq * 8), boff = lds_byte(wc * 32 + fr, fq * 8);
#define G_SA(b, h) (((b) * 2 + (h)) * HTB)
#define G_SB(b, h) ((4 + (b) * 2 + (h)) * HTB)
#define G_STAGE(bufoff, gbase, v0, v1) do { \
    __builtin_amdgcn_global_load_lds((const unsigned*)((const char*)(gbase) + (v0)), (LAS unsigned*)(lds + (bufoff) + ldsw), 16, 0, 0); \
    __builtin_amdgcn_global_load_lds((const unsigned*)((const char*)(gbase) + (v1)), (LAS unsigned*)(lds + (bufoff) + ldsw + 8192), 16, 0, 0); } while (0)
#define G_LDA(dst, b, h) do { _Pragma("unroll") for (int m = 0; m < 4; ++m) _Pragma("unroll") for (int k = 0; k < 2; ++k) dst[m][k] = *(const LAS bf16x8*)(lds + G_SA(b, h) + aoff + m * 2048 + k * 1024); } while (0)
#define G_LDB(dst, b, h) do { _Pragma("unroll") for (int n = 0; n < 2; ++n) _Pragma("unroll") for (int k = 0; k < 2; ++k) dst[n][k] = *(const LAS bf16x8*)(lds + G_SB(b, h) + boff + n * 2048 + k * 1024); } while (0)
#define G_MMA(ai, bj, At, Bt) do { __builtin_amdgcn_s_setprio(1); _Pragma("unroll") for (int m = 0; m < 4; ++m) _Pragma("unroll") for (int n = 0; n < 2; ++n) _Pragma("unroll") for (int k = 0; k < 2; ++k) \
    acc[ai][bj][m][n] = __builtin_amdgcn_mfma_f32_16x16x32_bf16(Bt[n][k], At[m][k], acc[ai][bj][m][n], 0, 0, 0); __builtin_amdgcn_s_setprio(0); } while (0)
#define G_WAIT_V(n) asm volatile("s_waitcnt vmcnt(" #n ")" ::: "memory")
#define G_WAIT_L(n) asm volatile("s_waitcnt lgkmcnt(" #n ")" ::: "memory")
#define G_BAR __builtin_amdgcn_s_barrier()
#define G_SCHED __builtin_amdgcn_sched_barrier(0)
  GUnit cur, nxt; int ui = 0;
  if (!gemm_unit(p, l, kind, single, 0, cur)) return;
  f32x4 acc[2][2][4][2];
#pragma unroll
  for (int a = 0; a < 2; ++a)
#pragma unroll
    for (int b = 0; b < 2; ++b)
#pragma unroll
      for (int m = 0; m < 4; ++m)
#pragma unroll
        for (int n = 0; n < 2; ++n) acc[a][b][m][n] = f32x4{0.f, 0.f, 0.f, 0.f};
  bf16x8 At[4][2], B0[2][2], B1[2][2];
  const char* cA = cur.A; const char* cB = cur.B;
  unsigned vc0 = (unsigned)(sR[0] * cur.ld + sC[0]) * 2u, vc1 = (unsigned)(sR[1] * cur.ld + sC[1]) * 2u;
  size_t hc = (size_t)128 * cur.ld * 2;
  G_STAGE(G_SB(0, 0), cB, vc0, vc1); G_STAGE(G_SA(0, 0), cA, vc0, vc1); G_STAGE(G_SB(0, 1), cB + hc, vc0, vc1); G_STAGE(G_SA(0, 1), cA + hc, vc0, vc1);
  if (wr == 1) G_BAR;
  G_WAIT_V(4); G_BAR;
  G_STAGE(G_SB(1, 0), cB + kstep, vc0, vc1); G_STAGE(G_SA(1, 0), cA + kstep, vc0, vc1); G_STAGE(G_SB(1, 1), cB + hc + kstep, vc0, vc1);
  G_WAIT_V(6); G_BAR;
  for (;;) {
    const bool has_next = gemm_unit(p, l, kind, single, ui + 1, nxt);
    const char* nA = has_next ? nxt.A : cA; const char* nB = has_next ? nxt.B : cB;
    const int nld = has_next ? nxt.ld : cur.ld;
    const unsigned vn0 = (unsigned)(sR[0] * nld + sC[0]) * 2u, vn1 = (unsigned)(sR[1] * nld + sC[1]) * 2u;
    const size_t hn = (size_t)128 * nld * 2;
    const int nt = cur.nt;
    for (int t = 0; t < nt; t += 2) {
      const bool last = (t == nt - 2);
      const char* a1 = cA + (size_t)(t + 1) * kstep;
      const char* a2 = last ? nA : cA + (size_t)(t + 2) * kstep; const char* b2 = last ? nB : cB + (size_t)(t + 2) * kstep;
      const char* a3 = a2 + kstep; const char* b3 = b2 + kstep;
      const unsigned w0 = last ? vn0 : vc0, w1 = last ? vn1 : vc1; const size_t h2 = last ? hn : hc;
      G_LDB(B0, 0, 0); G_SCHED; G_LDA(At, 0, 0); G_STAGE(G_SA(1, 1), a1 + hc, vc0, vc1);
      G_WAIT_L(8); G_BAR; G_WAIT_L(0); G_MMA(0, 0, At, B0); G_BAR; G_SCHED;
      G_LDB(B1, 0, 1); G_STAGE(G_SB(0, 0), b2, w0, w1);
      G_BAR; G_WAIT_L(0); G_MMA(0, 1, At, B1); G_BAR;
      G_LDA(At, 0, 1); G_STAGE(G_SA(0, 0), a2, w0, w1);
      G_BAR; G_WAIT_L(0); G_MMA(1, 0, At, B0); G_BAR; G_SCHED;
      G_STAGE(G_SB(0, 1), b2 + h2, w0, w1);
      G_WAIT_V(6); G_BAR; G_MMA(1, 1, At, B1); G_BAR;
      G_LDB(B0, 1, 0); G_SCHED; G_LDA(At, 1, 0); G_STAGE(G_SA(0, 1), a2 + h2, w0, w1);
      G_WAIT_L(8); G_BAR; G_WAIT_L(0); G_MMA(0, 0, At, B0); G_BAR; G_SCHED;
      G_LDB(B1, 1, 1); G_STAGE(G_SB(1, 0), b3, w0, w1);
      G_BAR; G_WAIT_L(0); G_MMA(0, 1, At, B1); G_BAR;
      G_LDA(At, 1, 1); G_STAGE(G_SA(1, 0), a3, w0, w1);
      G_BAR; G_WAIT_L(0); G_MMA(1, 0, At, B0); G_BAR; G_SCHED;
      G_STAGE(G_SB(1, 1), b3 + h2, w0, w1);
      G_WAIT_V(6); G_BAR; G_MMA(1, 1, At, B1); G_BAR;
    }
    gemm_epi(p, l, kind, cur, acc);
    if (!has_next) break;
#pragma unroll
    for (int a = 0; a < 2; ++a)
#pragma unroll
      for (int b = 0; b < 2; ++b)
#pragma unroll
        for (int m = 0; m < 4; ++m)
#pragma unroll
          for (int n = 0; n < 2; ++n) acc[a][b][m][n] = f32x4{0.f, 0.f, 0.f, 0.f};
    cur = nxt; cA = nA; cB = nB; vc0 = vn0; vc1 = vn1; hc = hn; ++ui;
  }
  G_WAIT_V(0);
  if (wr == 0) G_BAR;
  G_BAR;
#undef G_SA
#undef G_SB
#undef G_STAGE
#undef G_LDA
#undef G_LDB
#undef G_MMA
#undef G_WAIT_V
#undef G_WAIT_L
#undef G_BAR
#undef G_SCHED
}

__device__ __forceinline__ void signal_done(int* cnt) {
  asm volatile("s_waitcnt vmcnt(0)" ::: "memory");
  __syncthreads();
  if (threadIdx.x == 0) {
    __builtin_amdgcn_fence(__ATOMIC_RELEASE, "agent");
    asm volatile("s_waitcnt vmcnt(0)" ::: "memory");
    __hip_atomic_fetch_add(cnt, 1, __ATOMIC_RELAXED, __HIP_MEMORY_SCOPE_AGENT);
  }
}
__device__ __forceinline__ void wait_for(int* cnt, int need) {
  if (threadIdx.x == 0) {
    unsigned spins = 0;
    while (__hip_atomic_load(cnt, __ATOMIC_RELAXED, __HIP_MEMORY_SCOPE_AGENT) < need) { __builtin_amdgcn_s_sleep(8); if (++spins > (1u << 22)) break; }
    __builtin_amdgcn_fence(__ATOMIC_ACQUIRE, "agent");
    asm volatile("s_waitcnt vmcnt(0)" ::: "memory");
  }
  __syncthreads();
}
#define Q_HGP 128
#define Q_HGS (Q_HGP + 64)
#define Q_ATS (Q_HGS + 128)
#define Q_CVS (Q_ATS + 2)
#define Q_P3S (Q_CVS + 4)
#define Q_P4S (Q_P3S + 4)
#define Q_ATP (Q_P4S + 2048)
#define Q_CVP (Q_ATP + 512)
__device__ __forceinline__ void phase_p2(const Params& p, int l) {
  int* s_item = reinterpret_cast<int*>(smem + LDS_BYTES - 16);
  int* cnt_s = p.ctr + 2 + l; int* cnt_m = p.ctr + 4 + l;
  while (true) {
    if (threadIdx.x == 0) *s_item = atomicAdd(p.ctr + l, 1);
    __syncthreads();
    const int item = *s_item;
    __syncthreads();
    if (item >= Q_CVP) break;
    int kind, sub;
    if (item < Q_HGP) { kind = 0; sub = item; }
    else if (item < Q_HGS) { kind = 0; sub = 128 + item - Q_HGP; }
    else if (item < Q_ATS) { kind = 1; sub = 2048 + item - Q_HGS; }
    else if (item < Q_CVS) { kind = 2; sub = 512 + item - Q_ATS; }
    else if (item < Q_P3S) { kind = 3; sub = item - Q_CVS; }
    else if (item < Q_P4S) { kind = 4; sub = item - Q_P3S; }
    else if (item < Q_ATP) { kind = 1; sub = item - Q_P4S; }
    else { kind = 2; sub = item - Q_ATP; }
    if (kind == 0) item_hgrn(p, l, sub);
    else if (kind == 1) item_attn(p, l, sub);
    else if (kind == 2) item_conv(p, l, sub);
    else if (kind == 3) { wait_for(cnt_s, 64 + 128 + 2); gemm_run(p, l, 3, sub); }
    else { wait_for(cnt_m, 4); gemm_run(p, l, 4, sub); }
    if (item >= Q_HGP && item < Q_CVS) signal_done(cnt_s);
    else if (kind == 3) signal_done(cnt_m);
    __syncthreads();
  }
}

__global__ void __launch_bounds__(NTHR) fwd_mega(Params p, int ph_lo, int ph_hi) {
  cg::grid_group grid = cg::this_grid();
  if (threadIdx.x < 2) *reinterpret_cast<volatile unsigned*>(smem + LDS_BYTES - 32 + 4 * threadIdx.x) = 0u;
  __syncthreads();
  phase_prep(p);
  phase_norm(p, 0);
  grid.sync();
  if (threadIdx.x == 0) (void)xb_add(&p.bar[XB_XCNT(xb_xcc_id())], 1u);
#pragma unroll 1
  for (int l = 0; l < 2; ++l) {
    gemm_run(p, l, 1, -1);
    grid_bar(p.bar);
    phase_p2(p, l);
    grid_bar(p.bar);
    gemm_run(p, l, 3, -1);
    grid_bar(p.bar);
    gemm_run(p, l, 4, -1);
    if (l == 0) {
      grid_bar(p.bar);
      phase_norm(p, 1);
      grid_bar(p.bar);
    }
  }
}

extern "C" void kernel_launch(void* const* d_in, const int* in_sizes, int n_in, void* d_out,
                              int out_size, void* d_ws, size_t ws_size, hipStream_t stream) {
  static int grid_blocks = 0;
  if (!grid_blocks) {
    int dev = 0, cus = 0, per_cu = 0;
    (void)hipGetDevice(&dev);
    (void)hipDeviceGetAttribute(&cus, hipDeviceAttributeMultiprocessorCount, dev);
    (void)hipFuncSetAttribute((const void*)fwd_mega, hipFuncAttributeMaxDynamicSharedMemorySize, LDS_BYTES);
    (void)hipOccupancyMaxActiveBlocksPerMultiprocessor(&per_cu, fwd_mega, NTHR, LDS_BYTES);
    if (per_cu > 1) per_cu = 1;
    if (per_cu < 1) { fprintf(stderr, "occupancy query returned 0\n"); per_cu = 1; }
    grid_blocks = cus * per_cu;
  }
  Params p{};
  p.xp = (const float*)d_in[0]; p.xs = (const float*)d_in[1]; p.cconv = (const float*)d_in[2]; p.shg = (const float*)d_in[3];
  p.ck = (const float*)d_in[4]; p.cv = (const float*)d_in[5]; p.norm_g = (const float*)d_in[6]; p.w_in = (const float*)d_in[7];
  p.conv_w = (const float*)d_in[8]; p.lb_logits = (const float*)d_in[9]; p.hg_g = (const float*)d_in[10];
  p.q_g = (const float*)d_in[11]; p.k_g = (const float*)d_in[12]; p.w_br = (const float*)d_in[13]; p.w_out = (const float*)d_in[14];
  p.out = (float*)d_out;
  char* w = (char*)d_ws; size_t off = 0;
  auto take = [&](size_t bytes) { char* r = w + off; off += (bytes + 255) & ~(size_t)255; return r; };
  p.ctr = (int*)take(256);
  p.bar = (unsigned*)take((size_t)XCD_BAR_WORDS * 4);
  p.lbv = (float*)take(2 * 512 * 4);
  p.wt_in = (u16*)take((size_t)2 * 9216 * 1024 * 2);
  p.wt_br = (u16*)take((size_t)2 * 1024 * 1536 * 2);
  p.wt_out = (u16*)take((size_t)2 * 1024 * 1024 * 2);
  p.h = (u16*)take((size_t)NTOK * 1024 * 2);
  const size_t half = (size_t)NTOK * 512 * 2;
  p.u = (u16*)take(half); p.hv = (u16*)take(half);
  p.gbuf = take((size_t)256 * 131072); p.mbuf = take((size_t)256 * 131072);
  p.gza = (u16*)take(half); p.hq = (u16*)take(half); p.gzb = (u16*)take(half); p.sq = (u16*)take(half); p.gzc = (u16*)take(half);
  p.logf = (float*)take((size_t)NTOK * 512 * 4);
  p.m = (u16*)p.logf;
  if (off > ws_size) fprintf(stderr, "workspace too small: need %zu have %zu\n", off, ws_size);
  int lo = 0, hi = 10;
  void* args[] = {&p, &lo, &hi};
  hipError_t e = hipLaunchCooperativeKernel((void*)fwd_mega, dim3(grid_blocks), dim3(NTHR), args, LDS_BYTES, stream);
  if (e != hipSuccess) fprintf(stderr, "coop launch failed: %s (grid %d)\n", hipGetErrorString(e), grid_blocks);
}
```

```cpp
#include <hip/hip_runtime.h>
#include <hip/hip_cooperative_groups.h>
#include <cstdio>
#include <type_traits>
namespace cg = cooperative_groups;

typedef unsigned short u16;
using bf16x8 = __attribute__((ext_vector_type(8))) short;
using bf16x4 = __attribute__((ext_vector_type(4))) short;
using f32x4  = __attribute__((ext_vector_type(4))) float;

#define NTOK 65792
#define NP   65536
#define NTHR 512
#define LDS_BYTES 131328
#define EPSV 1e-6f

struct Params {
  const float* xp; const float* xs; const float* cconv; const float* shg; const float* ck; const float* cv;
  const float* norm_g; const float* w_in; const float* conv_w; const float* lb_logits; const float* hg_g;
  const float* q_g; const float* k_g; const float* w_br; const float* w_out;
  float* out;
  u16* wt_in; u16* wt_br; u16* wt_out;
  u16* h;
  u16* u; u16* hv;
  u16* gza; u16* hq; u16* gzb; u16* sq; u16* gzc;
  float* logf;
  u16* m;
  float* lbv;
  int* ctr;
  unsigned* bar;
  char* gbuf; char* mbuf;
};

extern __shared__ __attribute__((aligned(16))) char smem[];

__device__ __forceinline__ int otid() { int t = threadIdx.x; asm volatile("" : "+v"(t)); return t; }

__device__ __forceinline__ u16 f2bf(float f) {
  unsigned u = __float_as_uint(f);
  u += 0x7fffu + ((u >> 16) & 1u);
  return (u16)(u >> 16);
}
__device__ __forceinline__ float bf2f(u16 h) { return __uint_as_float(((unsigned)h) << 16); }
__device__ __forceinline__ float fexp(float x) { return __builtin_amdgcn_exp2f(x * 1.44269504f); }
__device__ __forceinline__ float flog(float x) { return __builtin_amdgcn_logf(x) * 0.69314718f; }
__device__ __forceinline__ float sigmoidf_(float x) { return __builtin_amdgcn_rcpf(1.f + fexp(-x)); }
__device__ __forceinline__ float siluf_(float x) { return x * __builtin_amdgcn_rcpf(1.f + fexp(-x)); }
__device__ __forceinline__ unsigned pack2_t(float a, float b) { unsigned r; asm volatile("s_nop 1\n\tv_cvt_pk_bf16_f32 %0, %1, %2" : "=v"(r) : "v"(a), "v"(b)); return r; }
__device__ __forceinline__ unsigned pack2(float a, float b) { unsigned r; asm volatile("v_cvt_pk_bf16_f32 %0, %1, %2" : "=v"(r) : "v"(a), "v"(b)); return r; }

#define OFF_Y      0L
#define OFF_CONVP  67371008L
#define OFF_CONVS  (OFF_CONVP + 65536L)
#define OFF_HGP    (OFF_CONVS + 32768L)
#define OFF_HGS    (OFF_HGP + 4194304L)
#define OFF_KP     (OFF_HGS + 2097152L)
#define OFF_KS     (OFF_KP + 67108864L)
#define OFF_VP     (OFF_KS + 262144L)
#define OFF_VS     (OFF_VP + 67108864L)

__device__ __forceinline__ int perm256(int v) {
  const int bj = v >> 7, wc = (v >> 5) & 3, n = (v >> 4) & 1, fq = (v >> 2) & 3, j = v & 3;
  return 128 * bj + 32 * wc + 8 * fq + 4 * n + j;
}
__device__ __forceinline__ int real_col(int V) {
  const int pn = V >> 8, v = V & 255;
  if (V >= 6144) return (V & ~255) + perm256(v);
  const int bj = v >> 7, wc = (v >> 5) & 3, n = (v >> 4) & 1, fq = (v >> 2) & 3, j = v & 3;
  if (pn < 8) {
    const int seg = (pn < 4) ? (bj ? 2 : 0) : (bj ? 3 : 1);
    return seg * 512 + (pn & 3) * 128 + 32 * wc + 8 * fq + 4 * n + j;
  }
  if (pn < 16) {
    const int seg = (pn - 8) >> 1;
    return (seg == 1) ? V : (V & ~255) + perm256(v);
  }
  const int s = (pn - 16) >> 1, head = ((pn - 16) & 1) * 4 + wc;
  const int d = (s == 0 || s == 3) ? (32 * bj + 8 * fq + 4 * n + j) : (32 * bj + 16 * n + 4 * fq + j);
  return 4096 + s * 512 + head * 64 + d;
}

#define XB_TMO      128
#define XB_XCNT(j)  (256  + 64 * (j))
#define XB_XSUB(j)  (1280 + 64 * (j))
#define XB_XGEN(j)  (2304 + 64 * (j))
#define XB_TOP      3328
#define XB_TOPGEN   3392
#define XCD_BAR_WORDS 3456
#define XB_SPIN_CAP (1u << 18)
#ifndef LAS
#define LAS __attribute__((address_space(3)))
#endif

__device__ __forceinline__ unsigned xb_ld(unsigned* p)              { return __hip_atomic_load(p, __ATOMIC_RELAXED, __HIP_MEMORY_SCOPE_AGENT); }
__device__ __forceinline__ unsigned xb_add(unsigned* p, unsigned v) { return __hip_atomic_fetch_add(p, v, __ATOMIC_RELAXED, __HIP_MEMORY_SCOPE_AGENT); }
__device__ __forceinline__ unsigned xb_xcc_id() { return (unsigned)__builtin_amdgcn_s_getreg((3 << 11) | 20) & 0xFu; }
#define XB_SPIN(cond, bar) do { unsigned _sp = 0; while (cond) { __builtin_amdgcn_s_sleep(1); \
    if ((++_sp & 255u) == 0u) { if (xb_ld(&(bar)[XB_TMO])) break; if (_sp > XB_SPIN_CAP) { atomicAdd(&(bar)[XB_TMO], 1u); break; } } } } while (0)

struct XcdBarrier {
    unsigned* bar; unsigned x;
    volatile LAS unsigned* st;
};

__device__ __forceinline__ XcdBarrier xcd_barrier_post(unsigned* bar, volatile LAS unsigned* st) {
    XcdBarrier b; b.bar = bar; b.x = xb_xcc_id(); b.st = st;
    if (threadIdx.x == 0) (void)xb_add(&bar[XB_XCNT(b.x)], 1u);
    return b;
}
__device__ __forceinline__ void xcd_barrier_complete(unsigned* bar, unsigned x, unsigned& nloc, unsigned& nx) {
    const unsigned G = gridDim.x * gridDim.y * gridDim.z;
    unsigned sum, cnt, mine, sp = 0u;
    for (;;) {
        sum = 0u; cnt = 0u; mine = 0u;
#pragma unroll
        for (unsigned j = 0; j < 16; ++j) { const unsigned c = xb_ld(&bar[XB_XCNT(j)]); sum += c; cnt += (c > 0u) ? 1u : 0u; mine = (j == x) ? c : mine; }
        if (sum == G) break;
        __builtin_amdgcn_s_sleep(1);
        if ((++sp & 255u) == 0u) { if (xb_ld(&bar[XB_TMO])) break; if (sp > XB_SPIN_CAP) { atomicAdd(&bar[XB_TMO], 1u); break; } }
    }
    nloc = mine > 0u ? mine : 1u; nx = cnt > 0u ? cnt : 1u;
}

__device__ __forceinline__ void xcd_barrier(const XcdBarrier& b) {
    asm volatile("s_waitcnt vmcnt(0)" ::: "memory");
    __syncthreads();
    if (threadIdx.x == 0) {
        unsigned* bar = b.bar;
        __builtin_amdgcn_s_waitcnt(0);
        unsigned nloc = b.st[0], nx = b.st[1];
        if (nloc == 0u) { xcd_barrier_complete(bar, b.x, nloc, nx); b.st[0] = nloc; b.st[1] = nx; }
        const unsigned old = xb_add(&bar[XB_XSUB(b.x)], 1u);
        const unsigned gen = old / nloc;
        if (old + 1u == (gen + 1u) * nloc) {
            __builtin_amdgcn_fence(__ATOMIC_RELEASE, "agent");
            asm volatile("s_waitcnt vmcnt(0)" ::: "memory");
            const unsigned og = xb_add(&bar[XB_TOP], 1u);
            const unsigned tg = og / nx;
            if (og + 1u == (tg + 1u) * nx) xb_add(&bar[XB_TOPGEN], 1u);
            else XB_SPIN(xb_ld(&bar[XB_TOPGEN]) == tg, bar);
            __builtin_amdgcn_fence(__ATOMIC_ACQUIRE, "agent");
            xb_add(&bar[XB_XGEN(b.x)], 1u);
            asm volatile("s_waitcnt vmcnt(0)" ::: "memory");
        } else {
            XB_SPIN(xb_ld(&bar[XB_XGEN(b.x)]) == gen, bar);
            __builtin_amdgcn_fence(__ATOMIC_ACQUIRE, "agent");
            asm volatile("s_waitcnt vmcnt(0)" ::: "memory");
        }
    }
    __syncthreads();
}


__device__ __forceinline__ void grid_bar(unsigned* bar) {
  XcdBarrier b; b.bar = bar; b.x = xb_xcc_id(); b.st = (volatile LAS unsigned*)(smem + LDS_BYTES - 32);
  xcd_barrier(b);
}

struct TDesc { const float* src; u16* dst; int ld, K, k0, n0, mode; };
__device__ __forceinline__ TDesc tile_desc(const Params& p, int t) {
  TDesc d; const int l = t / 2944; int r = t % 2944;
  if (r < 2304) { const int kt = r / 144, nt = r % 144;
    d.src = p.w_in + (long)l * 1024 * 9216; d.ld = 9216; d.dst = p.wt_in + (long)l * 9216 * 1024; d.K = 1024; d.k0 = kt * 64; d.n0 = nt * 64; d.mode = 1;
  } else if (r < 2304 + 384) { r -= 2304; const int br = r >> 7, kt = (r & 127) >> 4, nt = r & 15;
    d.src = p.w_br + (long)l * 1536 * 1024 + (long)br * 512 * 1024; d.ld = 1024; d.dst = p.wt_br + (long)(l * 3 + br) * 1024 * 512; d.K = 512; d.k0 = kt * 64; d.n0 = nt * 64; d.mode = 2;
  } else { r -= 2304 + 384; const int kt = r / 16, nt = r % 16;
    d.src = p.w_out + (long)l * 1024 * 1024; d.ld = 1024; d.dst = p.wt_out + (long)l * 1024 * 1024; d.K = 1024; d.k0 = kt * 64; d.n0 = nt * 64; d.mode = 0;
  }
  return d;
}
__device__ __forceinline__ void tt_load(const TDesc& d, float* t, int tid) {
#pragma unroll
  for (int i = 0; i < 2; ++i) {
    const int e = tid + i * NTHR, kk = e >> 4, q = e & 15, nv = d.n0 + 4 * q;
    const int col = (d.mode == 1) ? real_col(nv) : (d.mode == 2) ? (nv & ~255) + perm256(nv & 255) : nv;
    const float4 v = *reinterpret_cast<const float4*>(d.src + (long)(d.k0 + kk) * d.ld + col);
    float* w = t + kk * 65 + 4 * q; w[0] = v.x; w[1] = v.y; w[2] = v.z; w[3] = v.w;
  }
}
__device__ __forceinline__ void tt_store(const TDesc& d, const float* t, int tid) {
  const int nn = tid >> 3, c8 = tid & 7;
  float f[8];
#pragma unroll
  for (int i = 0; i < 8; ++i) f[i] = t[(8 * c8 + i) * 65 + nn];
  uint4 o; o.x = pack2(f[0], f[1]); o.y = pack2(f[2], f[3]); o.z = pack2(f[4], f[5]); o.w = pack2(f[6], f[7]);
  *reinterpret_cast<uint4*>(d.dst + (long)(d.n0 + nn) * d.K + d.k0 + 8 * c8) = o;
}

__device__ __forceinline__ void phase_prep(const Params& p) {
  if (blockIdx.x == 0) {
    for (int i = threadIdx.x; i < 512; i += NTHR) {
      float l0 = p.lb_logits[i], l1 = p.lb_logits[512 + i];
      p.lbv[i] = 0.f;
      p.lbv[512 + i] = 1.f / (1.f + expf(l0 - l1));
    }
    if (threadIdx.x < 16) p.ctr[threadIdx.x] = 0;
    for (int i = threadIdx.x; i < XCD_BAR_WORDS; i += NTHR) p.bar[i] = 0u;
  }
  const int tid = otid();
  float* t0 = reinterpret_cast<float*>(smem); float* t1 = t0 + 64 * 65;
  for (int t = blockIdx.x; t < 2 * 2944; t += 2 * gridDim.x) {
    const int tb = t + gridDim.x; const bool two = tb < 2 * 2944;
    const TDesc d0 = tile_desc(p, t), d1 = tile_desc(p, two ? tb : t);
    tt_load(d0, t0, tid);
    if (two) tt_load(d1, t1, tid);
    __syncthreads();
    tt_store(d0, t0, tid);
    if (two) tt_store(d1, t1, tid);
    __syncthreads();
  }
}

__device__ __forceinline__ void phase_norm(const Params& p, int l) {
  const int tid = otid(), wid = tid >> 6, lane = tid & 63;
  const float* g = p.norm_g + l * 1024;
  float4 gg[4];
#pragma unroll
  for (int i = 0; i < 4; ++i) gg[i] = *reinterpret_cast<const float4*>(g + (i * 64 + lane) * 4);
  for (int row = (blockIdx.x * 8 + wid) * 2; row < NTOK; row += gridDim.x * 16) {
    float4 v[2][4]; float ss[2] = {0.f, 0.f};
#pragma unroll
    for (int r = 0; r < 2; ++r) {
      const int rr = row + r;
      const float* x = (l == 0) ? (rr < NP ? p.xp + (long)rr * 1024 : p.xs + (long)(rr - NP) * 1024) : p.out + (long)rr * 1024;
#pragma unroll
      for (int i = 0; i < 4; ++i) v[r][i] = *reinterpret_cast<const float4*>(x + (i * 64 + lane) * 4);
    }
#pragma unroll
    for (int r = 0; r < 2; ++r) {
#pragma unroll
      for (int i = 0; i < 4; ++i) ss[r] += v[r][i].x * v[r][i].x + v[r][i].y * v[r][i].y + v[r][i].z * v[r][i].z + v[r][i].w * v[r][i].w;
    }
#pragma unroll
    for (int o = 32; o >= 1; o >>= 1) { ss[0] += __shfl_xor(ss[0], o); ss[1] += __shfl_xor(ss[1], o); }
#pragma unroll
    for (int r = 0; r < 2; ++r) {
      const float rstd = rsqrtf(ss[r] * (1.f / 1024.f) + EPSV);
#pragma unroll
      for (int i = 0; i < 4; ++i) {
        const int c = (i * 64 + lane) * 4;
        uint2 o2;
        o2.x = pack2(v[r][i].x * rstd * gg[i].x, v[r][i].y * rstd * gg[i].y);
        o2.y = pack2(v[r][i].z * rstd * gg[i].z, v[r][i].w * rstd * gg[i].w);
        *reinterpret_cast<uint2*>(p.h + (long)(row + r) * 1024 + c) = o2;
      }
    }
  }
}

__device__ __forceinline__ void item_conv(const Params& p, int l, int item) {
  const float* cw = p.conv_w + l * 3 * 512;
  for (int e = threadIdx.x; e < 128 * 64; e += NTHR) {
    int tok = item * 128 + (e >> 6), c = (e & 63) * 8;
    int t, b; bool samp = tok >= NP;
    if (!samp) { t = tok & 2047; b = tok >> 11; } else { int ts = tok - NP; t = ts & 15; b = ts >> 4; }
    float y[8];
#pragma unroll
    for (int i = 0; i < 8; ++i) y[i] = 0.f;
#pragma unroll
    for (int j = 0; j < 3; ++j) {
      int pi = t + j;
      float f[8];
      if (pi >= 2) {
        uint4 raw = *reinterpret_cast<const uint4*>(p.u + (long)(tok - 2 + j) * 512 + c);
        unsigned w[4] = {raw.x, raw.y, raw.z, raw.w};
#pragma unroll
        for (int i = 0; i < 4; ++i) { f[2 * i] = __uint_as_float(w[i] << 16); f[2 * i + 1] = __uint_as_float(w[i] & 0xffff0000u); }
      } else if (samp) {
        const float* ps = p.cconv + ((long)(l * 16 + b) * 2 + pi) * 512 + c;
#pragma unroll
        for (int i = 0; i < 8; ++i) f[i] = ps[i];
      } else {
#pragma unroll
        for (int i = 0; i < 8; ++i) f[i] = 0.f;
      }
#pragma unroll
      for (int i = 0; i < 8; ++i) y[i] += f[i] * cw[j * 512 + c + i];
    }
    uint4 graw = *reinterpret_cast<const uint4*>(p.gza + (long)tok * 512 + c);
    unsigned gw[4] = {graw.x, graw.y, graw.z, graw.w};
    uint4 o;
    unsigned ow[4];
#pragma unroll
    for (int i = 0; i < 4; ++i) {
      float g0 = __uint_as_float(gw[i] << 16), g1 = __uint_as_float(gw[i] & 0xffff0000u);
      ow[i] = pack2(g0 * y[2 * i], g1 * y[2 * i + 1]);
    }
    o.x = ow[0]; o.y = ow[1]; o.z = ow[2]; o.w = ow[3];
    *reinterpret_cast<uint4*>(p.gza + (long)tok * 512 + c) = o;
  }
}

#define HQS 0
#define HKS 17408
#define HKT 34816
#define HVT 53248
#define HPS 71680
#define HSP 80896
#define HTOT 115712
#define HER 117760
#define HEL 118272
#define HSSQ 118784
__device__ __forceinline__ void item_hgrn(const Params& p, int l, int sidx) {
  const int tid = otid(), wid = __builtin_amdgcn_readfirstlane(tid >> 6), lane = tid & 63, fr = lane & 15, fq = lane >> 4;
  const bool samp = sidx >= 128;
  int b, hh, T, tok0, nchunks;
  if (!samp) { b = sidx >> 2; hh = sidx & 3; T = 2048; tok0 = b * 2048; nchunks = 32; }
  else { int s = sidx - 128; b = s >> 2; hh = s & 3; T = 16; tok0 = NP + b * 16; nchunks = 1; }
  u16* Qs = reinterpret_cast<u16*>(smem + HQS);
  u16* Ks = reinterpret_cast<u16*>(smem + HKS);
  u16* KTs = reinterpret_cast<u16*>(smem + HKT);
  u16* VTs = reinterpret_cast<u16*>(smem + HVT);
  u16* Ps = reinterpret_cast<u16*>(smem + HPS);
  u16* SpT = reinterpret_cast<u16*>(smem + HSP);
  float* tot = reinterpret_cast<float*>(smem + HTOT);
  float* er = reinterpret_cast<float*>(smem + HER);
  float* el = reinterpret_cast<float*>(smem + HEL);
  float* ssq = reinterpret_cast<float*>(smem + HSSQ);

  f32x4 S[8];
  float* Sout = p.out + (samp ? OFF_HGS + ((long)(l * 16 + b) * 4 + hh) * 16384 : OFF_HGP + ((long)(l * 32 + b) * 4 + hh) * 16384);
  if (samp) {
    const float* S0 = p.shg + ((long)(l * 16 + b) * 4 + hh) * 16384;
#pragma unroll
    for (int n = 0; n < 8; ++n)
#pragma unroll
      for (int j = 0; j < 4; ++j) S[n][j] = S0[(16 * wid + fq * 4 + j) * 128 + n * 16 + fr];
  } else {
#pragma unroll
    for (int n = 0; n < 8; ++n) S[n] = f32x4{0.f, 0.f, 0.f, 0.f};
  }
  const float* hg = p.hg_g + l * 128;
  const int c = tid & 127, qd = wid >> 1;
  float hgv[4];
#pragma unroll
  for (int n = 0; n < 4; ++n) hgv[n] = hg[(wid >> 2) * 64 + n * 16 + fr];

  float lf[16]; unsigned qraw[16]; uint4 vraw[2];
#define HG_LOAD_CHUNK(CH) do { \
    const int t0_ = (CH) * 64; \
    _Pragma("unroll") for (int i = 0; i < 16; ++i) { \
      const int t_ = t0_ + qd * 16 + i; \
      const long rb_ = (long)(tok0 + (t_ < T ? t_ : T - 1)) * 512 + hh * 128 + c; \
      lf[i] = p.logf[rb_]; qraw[i] = p.hq[rb_]; } \
    _Pragma("unroll") for (int i = 0; i < 2; ++i) { \
      const int e = tid + i * NTHR, s = e >> 4, dv0 = (e & 15) * 8; \
      vraw[i] = *reinterpret_cast<const uint4*>(p.hv + (long)(tok0 + (t0_ + s < T ? t0_ + s : T - 1)) * 512 + hh * 128 + dv0); } } while (0)
  HG_LOAD_CHUNK(0);

  for (int ch = 0; ch < nchunks; ++ch) {
    const int t0 = ch * 64;
    {
      float run = 0.f;
#pragma unroll
      for (int i = 0; i < 16; ++i) { if (t0 + qd * 16 + i >= T) { lf[i] = 0.f; qraw[i] = 0u; } run += lf[i]; }
      tot[qd * 128 + c] = run;
    }
#pragma unroll
    for (int i = 0; i < 2; ++i) {
      int e = tid + i * NTHR, s = e >> 4, dv0 = (e & 15) * 8;
      unsigned w[4] = {vraw[i].x, vraw[i].y, vraw[i].z, vraw[i].w};
      if (t0 + s >= T) { w[0] = 0u; w[1] = 0u; w[2] = 0u; w[3] = 0u; }
#pragma unroll
      for (int k = 0; k < 4; ++k) {
        VTs[(dv0 + 2 * k) * 72 + s] = (u16)(w[k] & 0xffffu);
        VTs[(dv0 + 2 * k + 1) * 72 + s] = (u16)(w[k] >> 16);
      }
    }
    __syncthreads();
    {
      float t0v = tot[c], t1v = tot[128 + c], t2v = tot[256 + c], t3v = tot[384 + c];
      float r = t0v + t1v;
      float e = (qd == 0 ? 0.f : qd == 1 ? t0v : qd == 2 ? r : r + t2v) - r;
      if (qd == 0) er[c] = fexp(fmaxf(r, -80.f));
      if (qd == 1) el[c] = fexp(fmaxf(t2v + t3v, -80.f));
      unsigned kpk[8];
#pragma unroll
      for (int i = 0; i < 16; ++i) {
        int tl = qd * 16 + i;
        float lfv = lf[i], qv = __uint_as_float(qraw[i] << 16);
        float kin = (t0 + tl < T) ? (1.f - fexp(lfv)) : 0.f;
        e += lfv;
        float eq = fexp(fminf(fmaxf(e, -80.f), 80.f));
        float ek = fexp(fminf(fmaxf(-e, -80.f), 80.f));
        const unsigned qk = pack2(qv * eq, kin * ek);
        const u16 qb = (u16)(qk & 0xffffu), kb = (u16)(qk >> 16);
        Qs[tl * 136 + c] = qb; Ks[tl * 136 + c] = kb;
        if (i & 1) kpk[i >> 1] |= ((unsigned)kb) << 16; else kpk[i >> 1] = kb;
      }
      *reinterpret_cast<uint4*>(KTs + c * 72 + qd * 16) = make_uint4(kpk[0], kpk[1], kpk[2], kpk[3]);
      *reinterpret_cast<uint4*>(KTs + c * 72 + qd * 16 + 8) = make_uint4(kpk[4], kpk[5], kpk[6], kpk[7]);
    }
    __syncthreads();
    if (ch + 1 < nchunks) HG_LOAD_CHUNK(ch + 1);
    unsigned gzr[4][4];
    {
      const int tt_ = wid & 3, dvh_ = wid >> 2;
#pragma unroll
      for (int j = 0; j < 4; ++j)
#pragma unroll
        for (int n = 0; n < 4; ++n) {
          int tl = tt_ * 16 + fq * 4 + j;
          int tr = t0 + tl < T ? t0 + tl : T - 1;
          gzr[j][n] = p.gzb[(long)(tok0 + tr) * 512 + hh * 128 + dvh_ * 64 + n * 16 + fr];
        }
    }
    {
      float e4[4];
#pragma unroll
      for (int j = 0; j < 4; ++j) e4[j] = er[16 * wid + fq * 4 + j];
#pragma unroll
      for (int n = 0; n < 8; ++n) {
#pragma unroll
        for (int j = 0; j < 4; ++j) S[n][j] *= e4[j];
        uint2 o2; o2.x = pack2(S[n][0], S[n][1]); o2.y = pack2(S[n][2], S[n][3]);
        *reinterpret_cast<uint2*>(SpT + (n * 16 + fr) * 136 + 16 * wid + fq * 4) = o2;
      }
    }
    {
      const int tt = wid >> 1;
#pragma unroll
      for (int q2 = 0; q2 < 2; ++q2) {
        const int st = 2 * (wid & 1) + q2;
        f32x4 pa = f32x4{0.f, 0.f, 0.f, 0.f};
        if (st <= tt) {
#pragma unroll
          for (int ks = 0; ks < 4; ++ks) {
            bf16x8 a = *reinterpret_cast<const bf16x8*>(Qs + (tt * 16 + fr) * 136 + ks * 32 + fq * 8);
            bf16x8 bb = *reinterpret_cast<const bf16x8*>(Ks + (st * 16 + fr) * 136 + ks * 32 + fq * 8);
            pa = __builtin_amdgcn_mfma_f32_16x16x32_bf16(a, bb, pa, 0, 0, 0);
          }
        }
#pragma unroll
        for (int j = 0; j < 4; ++j) {
          int trow = tt * 16 + fq * 4 + j, scol = st * 16 + fr;
          float v = (scol <= trow) ? pa[j] : 0.f;
          Ps[trow * 72 + scol] = f2bf(v);
        }
      }
    }
    __syncthreads();
    f32x4 oacc[4];
    const int tt = wid & 3, dvh = wid >> 2;
    {
#pragma unroll
      for (int n = 0; n < 4; ++n) oacc[n] = f32x4{0.f, 0.f, 0.f, 0.f};
#pragma unroll
      for (int ks = 0; ks < 2; ++ks) {
        bf16x8 a = *reinterpret_cast<const bf16x8*>(Ps + (tt * 16 + fr) * 72 + ks * 32 + fq * 8);
#pragma unroll
        for (int n = 0; n < 4; ++n) {
          bf16x8 bb = *reinterpret_cast<const bf16x8*>(VTs + (dvh * 64 + n * 16 + fr) * 72 + ks * 32 + fq * 8);
          oacc[n] = __builtin_amdgcn_mfma_f32_16x16x32_bf16(a, bb, oacc[n], 0, 0, 0);
        }
      }
#pragma unroll
      for (int ks = 0; ks < 4; ++ks) {
        bf16x8 a = *reinterpret_cast<const bf16x8*>(Qs + (tt * 16 + fr) * 136 + ks * 32 + fq * 8);
#pragma unroll
        for (int n = 0; n < 4; ++n) {
          bf16x8 bb = *reinterpret_cast<const bf16x8*>(SpT + (dvh * 64 + n * 16 + fr) * 136 + ks * 32 + fq * 8);
          oacc[n] = __builtin_amdgcn_mfma_f32_16x16x32_bf16(a, bb, oacc[n], 0, 0, 0);
        }
      }
#pragma unroll
      for (int j = 0; j < 4; ++j) {
        float ss = 0.f;
#pragma unroll
        for (int n = 0; n < 4; ++n) ss += oacc[n][j] * oacc[n][j];
        ss += __shfl_xor(ss, 1); ss += __shfl_xor(ss, 2); ss += __shfl_xor(ss, 4); ss += __shfl_xor(ss, 8);
        if (fr == 0) ssq[dvh * 64 + tt * 16 + fq * 4 + j] = ss;
      }
    }
    {
#pragma unroll
      for (int ks = 0; ks < 2; ++ks) {
        bf16x8 a = *reinterpret_cast<const bf16x8*>(KTs + (16 * wid + fr) * 72 + ks * 32 + fq * 8);
#pragma unroll
        for (int n = 0; n < 8; ++n) {
          bf16x8 bb = *reinterpret_cast<const bf16x8*>(VTs + (n * 16 + fr) * 72 + ks * 32 + fq * 8);
          S[n] = __builtin_amdgcn_mfma_f32_16x16x32_bf16(a, bb, S[n], 0, 0, 0);
        }
      }
      float e4[4];
#pragma unroll
      for (int j = 0; j < 4; ++j) e4[j] = el[16 * wid + fq * 4 + j];
#pragma unroll
      for (int n = 0; n < 8; ++n)
#pragma unroll
        for (int j = 0; j < 4; ++j) S[n][j] *= e4[j];
    }
    __syncthreads();
#pragma unroll
    for (int j = 0; j < 4; ++j) {
      int tl = tt * 16 + fq * 4 + j;
      if (t0 + tl < T) {
        float ss = ssq[tl] + ssq[64 + tl];
        float rstd = rsqrtf(ss * (1.f / 128.f) + EPSV);
#pragma unroll
        for (int n = 0; n < 4; ++n) {
          int dv = dvh * 64 + n * 16 + fr;
          long idx = (long)(tok0 + t0 + tl) * 512 + hh * 128 + dv;
          float g = __uint_as_float(gzr[j][n] << 16);
          p.gzb[idx] = f2bf(oacc[n][j] * rstd * hgv[n] * g);
        }
      }
    }
  }
#pragma unroll
  for (int n = 0; n < 8; ++n)
#pragma unroll
    for (int j = 0; j < 4; ++j) Sout[(16 * wid + fq * 4 + j) * 128 + n * 16 + fr] = S[n][j];
  __syncthreads();
#undef HG_LOAD_CHUNK
}

#define AKS 0
#define AVT 9216
__device__ __forceinline__ void item_attn(const Params& p, int l, int aidx) {
  const int tid = otid(), wid = __builtin_amdgcn_readfirstlane(tid >> 6), lane = tid & 63, fr = lane & 15, fq = lane >> 4;
  const bool samp = aidx >= 2048;
  int b, hd, nq, qpos0, ntiles; long tokq0;
  const float *kbase, *vbase, *kcache = nullptr, *vcache = nullptr;
  if (!samp) {
    int qb = 7 - (aidx >> 8); int r = aidx & 255; b = r >> 3; hd = r & 7;
    nq = 256; qpos0 = qb * 256; tokq0 = (long)b * 2048 + qpos0; ntiles = qb * 4 + 4;
    kbase = p.out + OFF_KP + ((long)l * 65536 + (long)b * 2048) * 512 + hd * 64;
    vbase = p.out + OFF_VP + ((long)l * 65536 + (long)b * 2048) * 512 + hd * 64;
  } else {
    int r = aidx - 2048; b = r >> 3; hd = r & 7;
    nq = 16; qpos0 = 1024; tokq0 = NP + (long)b * 16; ntiles = 17;
    kbase = p.out + OFF_KS + ((long)l * 256 + (long)b * 16) * 512 + hd * 64;
    vbase = p.out + OFF_VS + ((long)l * 256 + (long)b * 16) * 512 + hd * 64;
    kcache = p.ck + ((long)(l * 16 + b) * 1024) * 512 + hd * 64;
    vcache = p.cv + ((long)(l * 16 + b) * 1024) * 512 + hd * 64;
  }
  u16* Ks = reinterpret_cast<u16*>(smem + AKS);
  u16* VT = reinterpret_cast<u16*>(smem + AVT);

  bf16x8 qf[2][2];
  bool rowv[2];
#pragma unroll
  for (int n = 0; n < 2; ++n) {
    int row = 32 * wid + 16 * n + fr;
    rowv[n] = row < nq;
#pragma unroll
    for (int ks = 0; ks < 2; ++ks) {
      bf16x8 z = {0, 0, 0, 0, 0, 0, 0, 0};
      if (rowv[n]) z = *reinterpret_cast<const bf16x8*>(p.sq + (tokq0 + row) * 512 + hd * 64 + ks * 32 + fq * 8);
      qf[n][ks] = z;
    }
  }
  const bool wave_has_rows = (32 * wid) < nq;
  f32x4 oacc[4][2];
#pragma unroll
  for (int md = 0; md < 4; ++md)
#pragma unroll
    for (int n = 0; n < 2; ++n) oacc[md][n] = f32x4{0.f, 0.f, 0.f, 0.f};
  float carry[2] = {1.f, 1.f};
  const int wave_qmax = qpos0 + 32 * wid + 31;

  float4 kreg[2][2]; float vreg[2][8];
#define ATT_LOAD_TILE(KT, S) do { \
    _Pragma("unroll") for (int i = 0; i < 2; ++i) { \
      const int e = tid + i * NTHR, key = e >> 4, d0 = (e & 15) * 4, pos = (KT) * 64 + key; \
      const float* kp_ = kbase + (long)pos * 512; \
      if (samp) { const int pc_ = pos < 1039 ? pos : 1039; \
        kp_ = (pos < 1024) ? kcache + (long)pc_ * 512 : kbase + (long)(pc_ - 1024) * 512; } \
      kreg[S][i] = *reinterpret_cast<const float4*>(kp_ + d0); } \
    _Pragma("unroll") for (int i = 0; i < 8; ++i) { \
      const int pos = (KT) * 64 + 8 * wid + i; \
      const float* vp_ = vbase + (long)pos * 512; \
      if (samp) { const int pc_ = pos < 1039 ? pos : 1039; \
        vp_ = (pos < 1024) ? vcache + (long)pc_ * 512 : vbase + (long)(pc_ - 1024) * 512; } \
      vreg[S][i] = vp_[lane]; } } while (0)
  ATT_LOAD_TILE(ntiles - 1, 0);
  if (ntiles > 1) ATT_LOAD_TILE(ntiles - 2, 1);
  bool wave_done = !wave_has_rows;

  bool all_done = false;
  for (int kt0 = ntiles - 1; kt0 >= 0 && !all_done; kt0 -= 2) {
#pragma unroll
  for (int hs = 0; hs < 2; ++hs) {
    const int kt = kt0 - hs;
    if (kt < 0 || all_done) break;
#pragma unroll
    for (int i = 0; i < 2; ++i) {
      const int e = tid + i * NTHR, key = e >> 4, d0 = (e & 15) * 4;
      if (samp && kt * 64 + key >= 1040) kreg[hs][i] = make_float4(0.f, 0.f, 0.f, 0.f);
      uint2 k2; k2.x = pack2(kreg[hs][i].x, kreg[hs][i].y); k2.y = pack2(kreg[hs][i].z, kreg[hs][i].w);
      *reinterpret_cast<uint2*>(Ks + key * 72 + d0) = k2;
    }
    {
      if (samp) {
#pragma unroll
        for (int i = 0; i < 8; ++i) if (kt * 64 + 8 * wid + i >= 1040) vreg[hs][i] = 0.f;
      }
      uint4 v4; v4.x = pack2(vreg[hs][0], vreg[hs][1]); v4.y = pack2(vreg[hs][2], vreg[hs][3]); v4.z = pack2(vreg[hs][4], vreg[hs][5]); v4.w = pack2(vreg[hs][6], vreg[hs][7]);
      *reinterpret_cast<uint4*>(VT + lane * 72 + 8 * wid) = v4;
    }
    __syncthreads();
    if (kt > 1) ATT_LOAD_TILE(kt - 2, hs);
    if (!wave_done && kt * 64 < wave_qmax) {
      f32x4 z[4][2];
#pragma unroll
      for (int m = 0; m < 4; ++m) {
        bf16x8 a0 = *reinterpret_cast<const bf16x8*>(Ks + (m * 16 + fr) * 72 + fq * 8);
        bf16x8 a1 = *reinterpret_cast<const bf16x8*>(Ks + (m * 16 + fr) * 72 + 32 + fq * 8);
#pragma unroll
        for (int n = 0; n < 2; ++n) {
          f32x4 zz = f32x4{0.f, 0.f, 0.f, 0.f};
          zz = __builtin_amdgcn_mfma_f32_16x16x32_bf16(a0, qf[n][0], zz, 0, 0, 0);
          zz = __builtin_amdgcn_mfma_f32_16x16x32_bf16(a1, qf[n][1], zz, 0, 0, 0);
          z[m][n] = zz;
        }
      }
      unsigned pk[4][2][2];
      auto sb_weights = [&](auto MASKED) {
#pragma unroll
        for (int n = 0; n < 2; ++n) {
          const int qpos = qpos0 + 32 * wid + 16 * n + fr;
          float wgt[4][4], excl[4][4], later[4], TT[4];
#pragma unroll
          for (int m = 0; m < 4; ++m) {
            float f[4];
#pragma unroll
            for (int j = 0; j < 4; ++j) {
              const float e = fexp(fminf(-z[m][n][j], 80.f));
              const float sg = __builtin_amdgcn_rcpf(1.f + e);
              if (decltype(MASKED)::value) {
                const bool ok = (kt * 64 + m * 16 + fq * 4 + j) < qpos;
                wgt[m][j] = ok ? sg : 0.f;
                f[j] = ok ? e * sg : 1.f;
              } else { wgt[m][j] = sg; f[j] = e * sg; }
            }
            excl[m][3] = 1.f; excl[m][2] = f[3]; excl[m][1] = f[3] * f[2]; excl[m][0] = excl[m][1] * f[1];
            const float G = excl[m][0] * f[0];
            const float g1 = __shfl_xor(G, 16), g2 = __shfl_xor(G, 32), g3 = __shfl_xor(G, 48);
            later[m] = ((fq ^ 1) > fq ? g1 : 1.f) * ((fq ^ 2) > fq ? g2 : 1.f) * ((fq ^ 3) > fq ? g3 : 1.f);
            TT[m] = (G * g1) * (g2 * g3);
          }
          float lm[4]; lm[3] = carry[n]; lm[2] = lm[3] * TT[3]; lm[1] = lm[2] * TT[2]; lm[0] = lm[1] * TT[1];
#pragma unroll
          for (int m = 0; m < 4; ++m) {
            const float base = later[m] * lm[m];
            float pv[4];
#pragma unroll
            for (int j = 0; j < 4; ++j) pv[j] = wgt[m][j] * excl[m][j] * base;
            pk[m][n][0] = pack2(pv[0], pv[1]); pk[m][n][1] = pack2(pv[2], pv[3]);
          }
          carry[n] = lm[0] * TT[0];
        }
      };
      if (kt * 64 + 63 < qpos0 + 32 * wid) sb_weights(std::false_type{}); else sb_weights(std::true_type{});
#pragma unroll
      for (int kk = 0; kk < 2; ++kk) {
        bf16x8 pb[2];
#pragma unroll
        for (int n = 0; n < 2; ++n) {
          union { unsigned u[4]; bf16x8 v; } cv;
          cv.u[0] = pk[2 * kk][n][0]; cv.u[1] = pk[2 * kk][n][1]; cv.u[2] = pk[2 * kk + 1][n][0]; cv.u[3] = pk[2 * kk + 1][n][1];
          pb[n] = cv.v;
        }
#pragma unroll
        for (int md = 0; md < 4; ++md) {
          union { uint2 h[2]; bf16x8 v; } av;
          av.h[0] = *reinterpret_cast<const uint2*>(VT + (md * 16 + fr) * 72 + kk * 32 + fq * 4);
          av.h[1] = *reinterpret_cast<const uint2*>(VT + (md * 16 + fr) * 72 + kk * 32 + 16 + fq * 4);
#pragma unroll
          for (int n = 0; n < 2; ++n) oacc[md][n] = __builtin_amdgcn_mfma_f32_16x16x32_bf16(av.v, pb[n], oacc[md][n], 0, 0, 0);
        }
      }
      wave_done = __all(((carry[0] < 1e-36f) || !rowv[0]) && ((carry[1] < 1e-36f) || !rowv[1]));
    }
    if (__syncthreads_and(wave_done ? 1 : 0)) all_done = true;
  }
  }
#undef ATT_LOAD_TILE
  {
    uint2 gz[2][4];
#pragma unroll
    for (int n = 0; n < 2; ++n) {
      int row = 32 * wid + 16 * n + fr; if (row >= nq) row = nq - 1;
#pragma unroll
      for (int md = 0; md < 4; ++md) gz[n][md] = *reinterpret_cast<const uint2*>(p.gzc + (tokq0 + row) * 512 + hd * 64 + md * 16 + fq * 4);
    }
#pragma unroll
    for (int n = 0; n < 2; ++n) {
      const int row = 32 * wid + 16 * n + fr;
#pragma unroll
      for (int md = 0; md < 4; ++md) {
        const uint2 g2 = gz[n][md];
        float g0 = __uint_as_float(g2.x << 16), g1 = __uint_as_float(g2.x & 0xffff0000u);
        float g2f = __uint_as_float(g2.y << 16), g3 = __uint_as_float(g2.y & 0xffff0000u);
        uint2 o2; o2.x = pack2(oacc[md][n][0] * g0, oacc[md][n][1] * g1); o2.y = pack2(oacc[md][n][2] * g2f, oacc[md][n][3] * g3);
        if (row < nq) *reinterpret_cast<uint2*>(p.sq + (tokq0 + row) * 512 + hd * 64 + md * 16 + fq * 4) = o2;
      }
    }
  }
}

#ifndef LAS
#define LAS __attribute__((address_space(3)))
#endif
__device__ __forceinline__ int lds_byte(int r, int c) { const int st = (r >> 4) * 2 + (c >> 5), rr = r & 15, cc = c & 31, ob = rr * 64 + cc * 2; return st * 1024 + (ob ^ (((ob >> 9) & 1) << 5)); }
__device__ __forceinline__ void stage_rc(int b, int& R, int& C) { const int st = b / 1024, sb = b % 1024, swz = sb ^ (((sb >> 9) & 1) << 5); R = (st >> 1) * 16 + swz / 64; C = (st & 1) * 32 + (swz % 64) / 2; }

struct GUnit { const char* A; const char* B; int ld; int nt; int pm, pn, sub; };

__device__ __forceinline__ bool gemm_unit(const Params& p, int l, int kind, int single, int i, GUnit& u) {
  const int nN = (kind == 1) ? 24 : 4, nM = (kind == 1) ? 257 : 256, nwg = nM * nN, nsub = (kind == 3) ? 6 : 1;
  const int G = gridDim.x, c = blockIdx.x;
  const int ti = i / nsub; u.sub = i - ti * nsub;
  const long L = (single >= 0) ? (ti == 0 ? 0 : nwg) : (long)ti * G + c; if (L >= nwg) return false;
  int wgid = (int)L; { const int q = nwg / 8, r = nwg % 8, xcd = wgid % 8, off = wgid / 8; wgid = (xcd < r ? xcd * (q + 1) : r * (q + 1) + (xcd - r) * q) + off; }
  const int nig = 8 * nN, gid = wgid / nig, fm = gid * 8, gsz = (nM - fm) < 8 ? (nM - fm) : 8;
  u.pm = fm + ((wgid % nig) % gsz); u.pn = (wgid % nig) / gsz;
  if (single >= 0) { u.pm = 256; u.pn = single; }
  const u16* Win = p.wt_in + (long)l * 9216 * 1024;
  if (kind == 1) { u.A = (const char*)(p.h + (long)u.pm * 256 * 1024); u.B = (const char*)(Win + (long)u.pn * 256 * 1024); u.ld = 1024; }
  else if (kind == 4) { u.A = (const char*)(p.m + (long)u.pm * 256 * 1024); u.B = (const char*)(p.wt_out + (long)l * 1024 * 1024 + (long)u.pn * 256 * 1024); u.ld = 1024; }
  else {
    const int br = u.sub >> 1;
    if (u.sub & 1) { u.A = (const char*)(p.h + (long)u.pm * 256 * 1024); u.B = (const char*)(Win + (long)(6144 + br * 1024 + u.pn * 256) * 1024); u.ld = 1024; }
    else {
      const u16* O = (br == 0 ? p.gza : br == 1 ? p.gzb : p.sq);
      u.A = (const char*)(O + (long)u.pm * 256 * 512); u.B = (const char*)(p.wt_br + (long)(l * 3 + br) * 1024 * 512 + (long)u.pn * 256 * 512); u.ld = 512;
    }
  }
  u.nt = u.ld >> 6;
  return true;
}

__device__ __forceinline__ void gemm_epi(const Params& p, int l, int kind, const GUnit& u, f32x4 (&acc)[2][2][4][2]) {
  const int tid = otid(), wid = __builtin_amdgcn_readfirstlane(tid >> 6), lane = tid & 63, wr = wid >> 2, wc = wid & 3, fr = lane & 15, fq = lane >> 4;
  int row0 = u.pm * 256 + wr * 64 + fr;
  asm volatile("" : "+v"(row0));
  if (kind == 4) {
    const int col0 = u.pn * 256 + wc * 32 + 4 * fq;
    const float* xbase = (l == 0) ? (u.pm < 256 ? p.xp : p.xs - (long)NP * 1024) : p.out;
#pragma unroll
    for (int ai = 0; ai < 2; ++ai) {
      f32x4 xv[4][2][2];
#pragma unroll
      for (int m = 0; m < 4; ++m) {
        const float* xr = xbase + (long)(row0 + ai * 128 + m * 16) * 1024 + col0;
#pragma unroll
        for (int bj = 0; bj < 2; ++bj)
#pragma unroll
          for (int n = 0; n < 2; ++n) xv[m][bj][n] = *reinterpret_cast<const f32x4*>(xr + bj * 128 + n * 16);
      }
#pragma unroll
      for (int m = 0; m < 4; ++m) {
        float* yr = p.out + (long)(row0 + ai * 128 + m * 16) * 1024 + col0;
#pragma unroll
        for (int bj = 0; bj < 2; ++bj)
#pragma unroll
          for (int n = 0; n < 2; ++n) *reinterpret_cast<f32x4*>(yr + bj * 128 + n * 16) = xv[m][bj][n] + acc[ai][bj][m][n];
      }
      __builtin_amdgcn_sched_barrier(0);
    }
  } else if (kind == 3) {
    char* gbu = p.gbuf + (long)blockIdx.x * 131072;
    char* mbu = p.mbuf + (long)blockIdx.x * 131072;
    unsigned lo16 = (unsigned)tid * 16u;
    asm volatile("" : "+v"(lo16));
    const int br = u.sub >> 1;
    if (!(u.sub & 1)) {
#pragma unroll
      for (int ai = 0; ai < 2; ++ai)
#pragma unroll
        for (int bj = 0; bj < 2; ++bj)
#pragma unroll
          for (int m = 0; m < 4; ++m) {
            const int q = (ai * 2 + bj) * 4 + m;
            const f32x4 a0 = acc[ai][bj][m][0], a1 = acc[ai][bj][m][1];
            uint4 o;
            o.x = pack2(a0[0], a0[1]); o.y = pack2(a0[2], a0[3]); o.z = pack2(a1[0], a1[1]); o.w = pack2(a1[2], a1[3]);
            *reinterpret_cast<uint4*>((gbu + q * 8192) + lo16) = o;
          }
    } else {
#pragma unroll
      for (int ai = 0; ai < 2; ++ai) {
        uint4 g[2][4], mm[2][4];
#pragma unroll
        for (int bj = 0; bj < 2; ++bj)
#pragma unroll
          for (int m = 0; m < 4; ++m) {
            const int q = (ai * 2 + bj) * 4 + m;
            g[bj][m] = *reinterpret_cast<const uint4*>((gbu + q * 8192) + lo16);
            mm[bj][m] = *reinterpret_cast<const uint4*>((mbu + q * 8192) + lo16);
          }
#pragma unroll
        for (int bj = 0; bj < 2; ++bj)
#pragma unroll
          for (int m = 0; m < 4; ++m) {
            const int q = (ai * 2 + bj) * 4 + m;
            const uint4 yy = g[bj][m]; uint4 mo = mm[bj][m];
            mo.x = (br > 0) ? mo.x : 0u; mo.y = (br > 0) ? mo.y : 0u; mo.z = (br > 0) ? mo.z : 0u; mo.w = (br > 0) ? mo.w : 0u;
            f32x4 s0 = acc[ai][bj][m][0], s1 = acc[ai][bj][m][1];
#pragma unroll
            for (int j = 0; j < 4; ++j) { s0[j] = sigmoidf_(s0[j]); s1[j] = sigmoidf_(s1[j]); }
            uint4 o;
            o.x = pack2(__uint_as_float(yy.x << 16) * s0[0] + __uint_as_float(mo.x << 16), __uint_as_float(yy.x & 0xffff0000u) * s0[1] + __uint_as_float(mo.x & 0xffff0000u));
            o.y = pack2(__uint_as_float(yy.y << 16) * s0[2] + __uint_as_float(mo.y << 16), __uint_as_float(yy.y & 0xffff0000u) * s0[3] + __uint_as_float(mo.y & 0xffff0000u));
            o.z = pack2(__uint_as_float(yy.z << 16) * s1[0] + __uint_as_float(mo.z << 16), __uint_as_float(yy.z & 0xffff0000u) * s1[1] + __uint_as_float(mo.z & 0xffff0000u));
            o.w = pack2(__uint_as_float(yy.w << 16) * s1[2] + __uint_as_float(mo.w << 16), __uint_as_float(yy.w & 0xffff0000u) * s1[3] + __uint_as_float(mo.w & 0xffff0000u));
            if (br < 2) *reinterpret_cast<uint4*>((mbu + q * 8192) + lo16) = o;
            mm[bj][m] = o;
          }
        if (br == 2) {
          unsigned mo16 = (unsigned)((row0 - u.pm * 256) * 1024 + (wc * 32 + 8 * fq)) * 2u;
          asm volatile("" : "+v"(mo16));
          char* mrow = (char*)(p.m + (long)u.pm * 256 * 1024 + u.pn * 256);
#pragma unroll
          for (int bj = 0; bj < 2; ++bj)
#pragma unroll
            for (int m = 0; m < 4; ++m)
              *reinterpret_cast<uint4*>((mrow + ((ai * 128 + m * 16) * 1024 + bj * 128) * 2) + mo16) = mm[bj][m];
        }
        __builtin_amdgcn_sched_barrier(0);
      }
    }
  } else {
    const int pn = u.pn;
    if (pn < 8) {
      const int ch = (pn & 3) * 128 + wc * 32 + 8 * fq;
      if (pn < 4) {
#pragma unroll
        for (int ai = 0; ai < 2; ++ai)
#pragma unroll
          for (int m = 0; m < 4; ++m) {
            const int tok = row0 + ai * 128 + m * 16;
            const f32x4 u0 = acc[ai][1][m][0] * acc[ai][0][m][0], u1 = acc[ai][1][m][1] * acc[ai][0][m][1];
            uint4 o; o.x = pack2(u0[0], u0[1]); o.y = pack2(u0[2], u0[3]); o.z = pack2(u1[0], u1[1]); o.w = pack2(u1[2], u1[3]);
            *reinterpret_cast<uint4*>(p.u + (long)tok * 512 + ch) = o;
            if (tok < NP) {
              int tt = tok & 2047, bb = tok >> 11;
              if (tt >= 2046) { float* d = p.out + OFF_CONVP + ((long)(l * 32 + bb) * 2 + (tt - 2046)) * 512 + ch;
                *reinterpret_cast<f32x4*>(d) = u0; *reinterpret_cast<f32x4*>(d + 4) = u1; }
            } else {
              int ts = tok - NP, tt = ts & 15, bb = ts >> 4;
              if (tt >= 14) { float* d = p.out + OFF_CONVS + ((long)(l * 16 + bb) * 2 + (tt - 14)) * 512 + ch;
                *reinterpret_cast<f32x4*>(d) = u0; *reinterpret_cast<f32x4*>(d + 4) = u1; }
            }
          }
      } else {
#pragma unroll
        for (int ai = 0; ai < 2; ++ai)
#pragma unroll
          for (int m = 0; m < 4; ++m) {
            const int tok = row0 + ai * 128 + m * 16;
            const f32x4 b0 = acc[ai][0][m][0], b1 = acc[ai][0][m][1], z0 = acc[ai][1][m][0], z1 = acc[ai][1][m][1];
            uint4 o;
            o.x = pack2(b0[0] * siluf_(z0[0]), b0[1] * siluf_(z0[1])); o.y = pack2(b0[2] * siluf_(z0[2]), b0[3] * siluf_(z0[3]));
            o.z = pack2(b1[0] * siluf_(z1[0]), b1[1] * siluf_(z1[1])); o.w = pack2(b1[2] * siluf_(z1[2]), b1[3] * siluf_(z1[3]));
            *reinterpret_cast<uint4*>(p.gza + (long)tok * 512 + ch) = o;
          }
      }
    } else if (pn < 16) {
      const int seg = (pn - 8) >> 1, cb = ((pn - 8) & 1) * 256 + wc * 32 + 4 * fq;
      if (seg == 1) {
        f32x4 lbv4[2][2];
#pragma unroll
        for (int bj = 0; bj < 2; ++bj)
#pragma unroll
          for (int n = 0; n < 2; ++n) lbv4[bj][n] = *reinterpret_cast<const f32x4*>(p.lbv + l * 512 + cb + bj * 128 + n * 16);
#pragma unroll
        for (int ai = 0; ai < 2; ++ai)
#pragma unroll
          for (int m = 0; m < 4; ++m) {
            float* dst = p.logf + (long)(row0 + ai * 128 + m * 16) * 512 + cb;
#pragma unroll
            for (int bj = 0; bj < 2; ++bj)
#pragma unroll
              for (int n = 0; n < 2; ++n) {
                const f32x4 v = acc[ai][bj][m][n], lb = lbv4[bj][n];
                f32x4 o;
#pragma unroll
                for (int j = 0; j < 4; ++j) o[j] = flog(lb[j] + (1.f - lb[j]) * sigmoidf_(v[j]));
                *reinterpret_cast<f32x4*>(dst + bj * 128 + n * 16) = o;
              }
          }
      } else {
        u16* dbase = (seg == 0) ? p.hq : (seg == 2) ? p.hv : p.gzb;
        const int cbp = ((pn - 8) & 1) * 256 + wc * 32 + 8 * fq;
#pragma unroll
        for (int ai = 0; ai < 2; ++ai)
#pragma unroll
          for (int m = 0; m < 4; ++m) {
            u16* dst = dbase + (long)(row0 + ai * 128 + m * 16) * 512 + cbp;
#pragma unroll
            for (int bj = 0; bj < 2; ++bj) {
              f32x4 v0 = acc[ai][bj][m][0], v1 = acc[ai][bj][m][1];
              if (seg == 3) {
#pragma unroll
                for (int j = 0; j < 4; ++j) { v0[j] = siluf_(v0[j]); v1[j] = siluf_(v1[j]); }
              }
              uint4 o; o.x = pack2(v0[0], v0[1]); o.y = pack2(v0[2], v0[3]); o.z = pack2(v1[0], v1[1]); o.w = pack2(v1[2], v1[3]);
              *reinterpret_cast<uint4*>(dst + bj * 128) = o;
            }
          }
      }
    } else {
      const int seg = (pn - 16) >> 1, head = ((pn - 16) & 1) * 4 + wc;
      const int dl = head * 64 + 4 * fq, dlp = head * 64 + 8 * fq;
      if (seg < 2) {
        const float* gp = (seg == 0) ? p.q_g + l * 64 + 8 * fq : p.k_g + l * 64 + 4 * fq;
        f32x4 g4[2][2];
#pragma unroll
        for (int bj = 0; bj < 2; ++bj)
#pragma unroll
          for (int n = 0; n < 2; ++n) g4[bj][n] = *reinterpret_cast<const f32x4*>(gp + 32 * bj + (seg == 0 ? 4 * n : 16 * n));
        float* kP = p.out + OFF_KP + (long)l * 65536 * 512;
        float* kS = p.out + OFF_KS + (long)l * 256 * 512 - (long)NP * 512;
        float* kb = (u.pm < 256) ? kP : kS;
#pragma unroll
        for (int ai = 0; ai < 2; ++ai)
#pragma unroll
          for (int m = 0; m < 4; ++m) {
            const int tok = row0 + ai * 128 + m * 16;
            float ss = 0.f;
#pragma unroll
            for (int bj = 0; bj < 2; ++bj)
#pragma unroll
              for (int n = 0; n < 2; ++n) { f32x4 v = acc[ai][bj][m][n]; ss += v[0] * v[0] + v[1] * v[1] + v[2] * v[2] + v[3] * v[3]; }
            ss += __shfl_xor(ss, 16); ss += __shfl_xor(ss, 32);
            const float rstd = rsqrtf(ss * (1.f / 64.f) + EPSV) * (seg == 0 ? 0.125f : 1.f);
#pragma unroll
            for (int bj = 0; bj < 2; ++bj) {
              const f32x4 v0 = acc[ai][bj][m][0] * rstd * g4[bj][0], v1 = acc[ai][bj][m][1] * rstd * g4[bj][1];
              if (seg == 1) {
                *reinterpret_cast<f32x4*>(kb + (long)tok * 512 + dl + 32 * bj) = v0;
                *reinterpret_cast<f32x4*>(kb + (long)tok * 512 + dl + 32 * bj + 16) = v1;
              } else {
                uint4 o; o.x = pack2(v0[0], v0[1]); o.y = pack2(v0[2], v0[3]); o.z = pack2(v1[0], v1[1]); o.w = pack2(v1[2], v1[3]);
                *reinterpret_cast<uint4*>(p.sq + (long)tok * 512 + dlp + 32 * bj) = o;
              }
            }
          }
      } else if (seg == 2) {
        float* vP = p.out + OFF_VP + (long)l * 65536 * 512;
        float* vS = p.out + OFF_VS + (long)l * 256 * 512 - (long)NP * 512;
        float* vb = (u.pm < 256) ? vP : vS;
#pragma unroll
        for (int ai = 0; ai < 2; ++ai)
#pragma unroll
          for (int m = 0; m < 4; ++m) {
            float* dst = vb + (long)(row0 + ai * 128 + m * 16) * 512 + dl;
#pragma unroll
            for (int bj = 0; bj < 2; ++bj)
#pragma unroll
              for (int n = 0; n < 2; ++n) *reinterpret_cast<f32x4*>(dst + 32 * bj + 16 * n) = acc[ai][bj][m][n];
          }
      } else {
#pragma unroll
        for (int ai = 0; ai < 2; ++ai)
#pragma unroll
          for (int m = 0; m < 4; ++m) {
            u16* dst = p.gzc + (long)(row0 + ai * 128 + m * 16) * 512 + dlp;
#pragma unroll
            for (int bj = 0; bj < 2; ++bj) {
              f32x4 v0 = acc[ai][bj][m][0], v1 = acc[ai][bj][m][1];
#pragma unroll
              for (int j = 0; j < 4; ++j) { v0[j] = siluf_(v0[j]); v1[j] = siluf_(v1[j]); }
              uint4 o; o.x = pack2(v0[0], v0[1]); o.y = pack2(v0[2], v0[3]); o.z = pack2(v1[0], v1[1]); o.w = pack2(v1[2], v1[3]);
              *reinterpret_cast<uint4*>(dst + 32 * bj) = o;
            }
          }
      }
    }
  }
}

__device__ __forceinline__ void gemm_run(const Params& p, int l, int kind, int single) {
  LAS unsigned char* lds = (LAS unsigned char*)smem;
  const int tid = otid(), wid = __builtin_amdgcn_readfirstlane(tid >> 6), lane = tid & 63, wr = wid >> 2, wc = wid & 3, fr = lane & 15, fq = lane >> 4;
  constexpr int HTB = 128 * 64 * 2;
  int sR[2], sC[2];
#pragma unroll
  for (int i = 0; i < 2; ++i) stage_rc(tid * 16 + i * 8192, sR[i], sC[i]);
  const size_t kstep = 128;
  const unsigned ldsw = (unsigned)wid * 1024u;
  const int aoff = lds_byte(wr * 64 + fr, fq * 8), boff = lds_byte(wc * 32 + fr, fq * 8);
#define G_SA(b, h) (((b) * 2 + (h)) * HTB)
#define G_SB(b, h) ((4 + (b) * 2 + (h)) * HTB)
#define G_STAGE(bufoff, gbase, v0, v1) do { \
    __builtin_amdgcn_global_load_lds((const unsigned*)((const char*)(gbase) + (v0)), (LAS unsigned*)(lds + (bufoff) + ldsw), 16, 0, 0); \
    __builtin_amdgcn_global_load_lds((const unsigned*)((const char*)(gbase) + (v1)), (LAS unsigned*)(lds + (bufoff) + ldsw + 8192), 16, 0, 0); } while (0)
#define G_LDA(dst, b, h) do { _Pragma("unroll") for (int m = 0; m < 4; ++m) _Pragma("unroll") for (int k = 0; k < 2; ++k) dst[m][k] = *(const LAS bf16x8*)(lds + G_SA(b, h) + aoff + m * 2048 + k * 1024); } while (0)
#define G_LDB(dst, b, h) do { _Pragma("unroll") for (int n = 0; n < 2; ++n) _Pragma("unroll") for (int k = 0; k < 2; ++k) dst[n][k] = *(const LAS bf16x8*)(lds + G_SB(b, h) + boff + n * 2048 + k * 1024); } while (0)
#define G_MMA(ai, bj, At, Bt) do { __builtin_amdgcn_s_setprio(1); _Pragma("unroll") for (int m = 0; m < 4; ++m) _Pragma("unroll") for (int n = 0; n < 2; ++n) _Pragma("unroll") for (int k = 0; k < 2; ++k) \
    acc[ai][bj][m][n] = __builtin_amdgcn_mfma_f32_16x16x32_bf16(Bt[n][k], At[m][k], acc[ai][bj][m][n], 0, 0, 0); __builtin_amdgcn_s_setprio(0); } while (0)
#define G_WAIT_V(n) asm volatile("s_waitcnt vmcnt(" #n ")" ::: "memory")
#define G_WAIT_L(n) asm volatile("s_waitcnt lgkmcnt(" #n ")" ::: "memory")
#define G_BAR __builtin_amdgcn_s_barrier()
#define G_SCHED __builtin_amdgcn_sched_barrier(0)
  GUnit cur, nxt; int ui = 0;
  if (!gemm_unit(p, l, kind, single, 0, cur)) return;
  f32x4 acc[2][2][4][2];
#pragma unroll
  for (int a = 0; a < 2; ++a)
#pragma unroll
    for (int b = 0; b < 2; ++b)
#pragma unroll
      for (int m = 0; m < 4; ++m)
#pragma unroll
        for (int n = 0; n < 2; ++n) acc[a][b][m][n] = f32x4{0.f, 0.f, 0.f, 0.f};
  bf16x8 At[4][2], B0[2][2], B1[2][2];
  const char* cA = cur.A; const char* cB = cur.B;
  unsigned vc0 = (unsigned)(sR[0] * cur.ld + sC[0]) * 2u, vc1 = (unsigned)(sR[1] * cur.ld + sC[1]) * 2u;
  size_t hc = (size_t)128 * cur.ld * 2;
  G_STAGE(G_SB(0, 0), cB, vc0, vc1); G_STAGE(G_SA(0, 0), cA, vc0, vc1); G_STAGE(G_SB(0, 1), cB + hc, vc0, vc1); G_STAGE(G_SA(0, 1), cA + hc, vc0, vc1);
  if (wr == 1) G_BAR;
  G_WAIT_V(4); G_BAR;
  G_STAGE(G_SB(1, 0), cB + kstep, vc0, vc1); G_STAGE(G_SA(1, 0), cA + kstep, vc0, vc1); G_STAGE(G_SB(1, 1), cB + hc + kstep, vc0, vc1);
  G_WAIT_V(6); G_BAR;
  for (;;) {
    const bool has_next = gemm_unit(p, l, kind, single, ui + 1, nxt);
    const char* nA = has_next ? nxt.A : cA; const char* nB = has_next ? nxt.B : cB;
    const int nld = has_next ? nxt.ld : cur.ld;
    const unsigned vn0 = (unsigned)(sR[0] * nld + sC[0]) * 2u, vn1 = (unsigned)(sR[1] * nld + sC[1]) * 2u;
    const size_t hn = (size_t)128 * nld * 2;
    const int nt = cur.nt;
    for (int t = 0; t < nt; t += 2) {
      const bool last = (t == nt - 2);
      const char* a1 = cA + (size_t)(t + 1) * kstep;
      const char* a2 = last ? nA : cA + (size_t)(t + 2) * kstep; const char* b2 = last ? nB : cB + (size_t)(t + 2) * kstep;
      const char* a3 = a2 + kstep; const char* b3 = b2 + kstep;
      const unsigned w0 = last ? vn0 : vc0, w1 = last ? vn1 : vc1; const size_t h2 = last ? hn : hc;
      G_LDB(B0, 0, 0); G_SCHED; G_LDA(At, 0, 0); G_STAGE(G_SA(1, 1), a1 + hc, vc0, vc1);
      G_WAIT_L(8); G_BAR; G_WAIT_L(0); G_MMA(0, 0, At, B0); G_BAR; G_SCHED;
      G_LDB(B1, 0, 1); G_STAGE(G_SB(0, 0), b2, w0, w1);
      G_BAR; G_WAIT_L(0); G_MMA(0, 1, At, B1); G_BAR;
      G_LDA(At, 0, 1); G_STAGE(G_SA(0, 0), a2, w0, w1);
      G_BAR; G_WAIT_L(0); G_MMA(1, 0, At, B0); G_BAR; G_SCHED;
      G_STAGE(G_SB(0, 1), b2 + h2, w0, w1);
      G_WAIT_V(6); G_BAR; G_MMA(1, 1, At, B1); G_BAR;
      G_LDB(B0, 1, 0); G_SCHED; G_LDA(At, 1, 0); G_STAGE(G_SA(0, 1), a2 + h2, w0, w1);
      G_WAIT_L(8); G_BAR; G_WAIT_L(0); G_MMA(0, 0, At, B0); G_BAR; G_SCHED;
      G_LDB(B1, 1, 1); G_STAGE(G_SB(1, 0), b3, w0, w1);
      G_BAR; G_WAIT_L(0); G_MMA(0, 1, At, B1); G_BAR;
      G_LDA(At, 1, 1); G_STAGE(G_SA(1, 0), a3, w0, w1);
      G_BAR; G_WAIT_L(0); G_MMA(1, 0, At, B0); G_BAR; G_SCHED;
      G_STAGE(G_SB(1, 1), b3 + h2, w0, w1);
      G_WAIT_V(6); G_BAR; G_MMA(1, 1, At, B1); G_BAR;
    }
    gemm_epi(p, l, kind, cur, acc);
    if (!has_next) break;
#pragma unroll
    for (int a = 0; a < 2; ++a)
#pragma unroll
      for (int b = 0; b < 2; ++b)
#pragma unroll
        for (int m = 0; m < 4; ++m)
#pragma unroll
          for (int n = 0; n < 2; ++n) acc[a][b][m][n] = f32x4{0.f, 0.f, 0.f, 0.f};
    cur = nxt; cA = nA; cB = nB; vc0 = vn0; vc1 = vn1; hc = hn; ++ui;
  }
  G_WAIT_V(0);
  if (wr == 0) G_BAR;
  G_BAR;
#undef G_SA
#undef G_SB
#undef G_STAGE
#undef G_LDA
#undef G_LDB
#undef G_MMA
#undef G_WAIT_V
#undef G_WAIT_L
#undef G_BAR
#undef G_SCHED
}

__device__ __forceinline__ void signal_done(int* cnt) {
  asm volatile("s_waitcnt vmcnt(0)" ::: "memory");
  __syncthreads();
  if (threadIdx.x == 0) {
    __builtin_amdgcn_fence(__ATOMIC_RELEASE, "agent");
    asm volatile("s_waitcnt vmcnt(0)" ::: "memory");
    __hip_atomic_fetch_add(cnt, 1, __ATOMIC_RELAXED, __HIP_MEMORY_SCOPE_AGENT);
  }
}
__device__ __forceinline__ void wait_for(int* cnt, int need) {
  if (threadIdx.x == 0) {
    unsigned spins = 0;
    while (__hip_atomic_load(cnt, __ATOMIC_RELAXED, __HIP_MEMORY_SCOPE_AGENT) < need) { __builtin_amdgcn_s_sleep(8); if (++spins > (1u << 22)) break; }
    __builtin_amdgcn_fence(__ATOMIC_ACQUIRE, "agent");
    asm volatile("s_waitcnt vmcnt(0)" ::: "memory");
  }
  __syncthreads();
}
#define Q_HGP 128
#define Q_HGS (Q_HGP + 64)
#define Q_ATS (Q_HGS + 128)
#define Q_CVS (Q_ATS + 2)
#define Q_P3S (Q_CVS + 4)
#define Q_P4S (Q_P3S + 4)
#define Q_ATP (Q_P4S + 2048)
#define Q_CVP (Q_ATP + 512)
__device__ __forceinline__ void phase_p2(const Params& p, int l) {
  int* s_item = reinterpret_cast<int*>(smem + LDS_BYTES - 16);
  int* cnt_s = p.ctr + 2 + l; int* cnt_m = p.ctr + 4 + l;
  while (true) {
    if (threadIdx.x == 0) *s_item = atomicAdd(p.ctr + l, 1);
    __syncthreads();
    const int item = *s_item;
    __syncthreads();
    if (item >= Q_CVP) break;
    int kind, sub;
    if (item < Q_HGP) { kind = 0; sub = item; }
    else if (item < Q_HGS) { kind = 0; sub = 128 + item - Q_HGP; }
    else if (item < Q_ATS) { kind = 1; sub = 2048 + item - Q_HGS; }
    else if (item < Q_CVS) { kind = 2; sub = 512 + item - Q_ATS; }
    else if (item < Q_P3S) { kind = 3; sub = item - Q_CVS; }
    else if (item < Q_P4S) { kind = 4; sub = item - Q_P3S; }
    else if (item < Q_ATP) { kind = 1; sub = item - Q_P4S; }
    else { kind = 2; sub = item - Q_ATP; }
    if (kind == 0) item_hgrn(p, l, sub);
    else if (kind == 1) item_attn(p, l, sub);
    else if (kind == 2) item_conv(p, l, sub);
    else if (kind == 3) { wait_for(cnt_s, 64 + 128 + 2); gemm_run(p, l, 3, sub); }
    else { wait_for(cnt_m, 4); gemm_run(p, l, 4, sub); }
    if (item >= Q_HGP && item < Q_CVS) signal_done(cnt_s);
    else if (kind == 3) signal_done(cnt_m);
    __syncthreads();
  }
}

__global__ void __launch_bounds__(NTHR) fwd_mega(Params p, int ph_lo, int ph_hi) {
  cg::grid_group grid = cg::this_grid();
  if (threadIdx.x < 2) *reinterpret_cast<volatile unsigned*>(smem + LDS_BYTES - 32 + 4 * threadIdx.x) = 0u;
  __syncthreads();
  phase_prep(p);
  phase_norm(p, 0);
  grid.sync();
  if (threadIdx.x == 0) (void)xb_add(&p.bar[XB_XCNT(xb_xcc_id())], 1u);
#pragma unroll 1
  for (int l = 0; l < 2; ++l) {
    gemm_run(p, l, 1, -1);
    grid_bar(p.bar);
    phase_p2(p, l);
    grid_bar(p.bar);
    gemm_run(p, l, 3, -1);
    grid_bar(p.bar);
    gemm_run(p, l, 4, -1);
    if (l == 0) {
      grid_bar(p.bar);
      phase_norm(p, 1);
      grid_bar(p.bar);
    }
  }
}

extern "C" void kernel_launch(void* const* d_in, const int* in_sizes, int n_in, void* d_out,
                              int out_size, void* d_ws, size_t ws_size, hipStream_t stream) {
  static int grid_blocks = 0;
  if (!grid_blocks) {
    int dev = 0, cus = 0, per_cu = 0;
    (void)hipGetDevice(&dev);
    (void)hipDeviceGetAttribute(&cus, hipDeviceAttributeMultiprocessorCount, dev);
    (void)hipFuncSetAttribute((const void*)fwd_mega, hipFuncAttributeMaxDynamicSharedMemorySize, LDS_BYTES);
    (void)hipOccupancyMaxActiveBlocksPerMultiprocessor(&per_cu, fwd_mega, NTHR, LDS_BYTES);
    if (per_cu > 1) per_cu = 1;
    if (per_cu < 1) { fprintf(stderr, "occupancy query returned 0\n"); per_cu = 1; }
    grid_blocks = cus * per_cu;
  }
  Params p{};
  p.xp = (const float*)d_in[0]; p.xs = (const float*)d_in[1]; p.cconv = (const float*)d_in[2]; p.shg = (const float*)d_in[3];
  p.ck = (const float*)d_in[4]; p.cv = (const float*)d_in[5]; p.norm_g = (const float*)d_in[6]; p.w_in = (const float*)d_in[7];
  p.conv_w = (const float*)d_in[8]; p.lb_logits = (const float*)d_in[9]; p.hg_g = (const float*)d_in[10];
  p.q_g = (const float*)d_in[11]; p.k_g = (const float*)d_in[12]; p.w_br = (const float*)d_in[13]; p.w_out = (const float*)d_in[14];
  p.out = (float*)d_out;
  char* w = (char*)d_ws; size_t off = 0;
  auto take = [&](size_t bytes) { char* r = w + off; off += (bytes + 255) & ~(size_t)255; return r; };
  p.ctr = (int*)take(256);
  p.bar = (unsigned*)take((size_t)XCD_BAR_WORDS * 4);
  p.lbv = (float*)take(2 * 512 * 4);
  p.wt_in = (u16*)take((size_t)2 * 9216 * 1024 * 2);
  p.wt_br = (u16*)take((size_t)2 * 1024 * 1536 * 2);
  p.wt_out = (u16*)take((size_t)2 * 1024 * 1024 * 2);
  p.h = (u16*)take((size_t)NTOK * 1024 * 2);
  const size_t half = (size_t)NTOK * 512 * 2;
  p.u = (u16*)take(half); p.hv = (u16*)take(half);
  p.gbuf = take((size_t)256 * 131072); p.mbuf = take((size_t)256 * 131072);
  p.gza = (u16*)take(half); p.hq = (u16*)take(half); p.gzb = (u16*)take(half); p.sq = (u16*)take(half); p.gzc = (u16*)take(half);
  p.logf = (float*)take((size_t)NTOK * 512 * 4);
  p.m = (u16*)p.logf;
  if (off > ws_size) fprintf(stderr, "workspace too small: need %zu have %zu\n", off, ws_size);
  int lo = 0, hi = 10;
  void* args[] = {&p, &lo, &hi};
  hipError_t e = hipLaunchCooperativeKernel((void*)fwd_mega, dim3(grid_blocks), dim3(NTHR), args, LDS_BYTES, stream);
  if (e != hipSuccess) fprintf(stderr, "coop launch failed: %s (grid %d)\n", hipGetErrorString(e), grid_blocks);
}
```
